# Optimizing an MI355X kernel written in HIP

```python
import jax
import jax.numpy as jnp
from jax import lax
import numpy as np

D_MODEL = 1024
BATCH = 8
SEQ = 4096
DEPTH = 4

MEM_LEN = 256

NSA_HEADS = 8
NSA_GROUPS = 2
NSA_HEAD_DIM = 64
CMP_BLOCK = 32
CMP_STRIDE = 16
CMP_HIDDEN = 4 * NSA_HEAD_DIM
SEL_BLOCK = 64
N_SEL = 16
WINDOW = 512
NSA_QBLOCK = 64
FORCE_SCORE = 1e4

GLA_HEADS = 4
GLA_HEAD_DK = 64
GLA_HEAD_DV = 128
GLA_RANK = 16
GLA_TAU = 16.0
GLA_CHUNK = 64

MEM_HEADS = 4
MEM_HEAD_DIM = 128

N_BRANCH = 3
BRANCH_WIDTH = NSA_HEADS * NSA_HEAD_DIM
MLP_HIDDEN = 4 * D_MODEL
ROPE_THETA = 500000.0
ROPE_FRACTION = 4
NORM_EPS = 1e-6

IN_SIZES = (
    NSA_HEADS * NSA_HEAD_DIM,
    NSA_GROUPS * NSA_HEAD_DIM,
    NSA_GROUPS * NSA_HEAD_DIM,
    NSA_GROUPS * NSA_HEAD_DIM,
    NSA_GROUPS * NSA_HEAD_DIM,
    NSA_GROUPS * NSA_HEAD_DIM,
    NSA_GROUPS * NSA_HEAD_DIM,
    NSA_HEADS * 3,
    GLA_HEADS * GLA_HEAD_DK,
    GLA_HEADS * GLA_HEAD_DK,
    GLA_HEADS * GLA_HEAD_DV,
    GLA_HEADS * GLA_HEAD_DV,
    GLA_RANK,
    MEM_HEADS * MEM_HEAD_DIM,
    N_BRANCH * D_MODEL,
)
D_IN = sum(IN_SIZES)

kernel_name = 'nsa_gla_memory_parallel_hybrid'


def rms_norm(x, g):
    xf = x.astype(jnp.float32)
    y = xf * lax.rsqrt(jnp.mean(xf * xf, axis=-1, keepdims=True) + NORM_EPS)
    return (y * g.astype(jnp.float32)).astype(x.dtype)


def split_heads(t, n):
    B, S, _ = t.shape
    return t.reshape(B, S, n, -1).transpose(0, 2, 1, 3)


def partial_rope(x, pos):
    rot = x.shape[-1] // ROPE_FRACTION
    half = rot // 2
    inv_freq = jnp.power(ROPE_THETA, -jnp.arange(half, dtype=jnp.float32) / half)
    ang = pos.astype(jnp.float32)[:, None, :, None] * inv_freq
    cos, sin = jnp.cos(ang), jnp.sin(ang)
    xf = x.astype(jnp.float32)
    x1, x2, rest = xf[..., :half], xf[..., half:rot], xf[..., rot:]
    out = jnp.concatenate([x1 * cos - x2 * sin, x2 * cos + x1 * sin, rest], axis=-1)
    return out.astype(x.dtype)


def masked_softmax(s, mask):
    s = jnp.where(mask, s.astype(jnp.float32), -jnp.inf)
    m = jnp.max(s, axis=-1, keepdims=True)
    m = jnp.where(jnp.isfinite(m), m, 0.0)
    p = jnp.exp(s - m)
    d = jnp.sum(p, axis=-1, keepdims=True)
    return p / jnp.where(d > 0, d, 1.0)


def nsa_attention(q, k_c, v_c, k_s, v_s, k_w, v_w, gate_logits, positions,
                  q_norm, k_norm, cmp_pe, cmp_w1, cmp_w2):
    B, S, _ = q.shape
    H, G, dh, QB = NSA_HEADS, NSA_GROUPS, NSA_HEAD_DIM, NSA_QBLOCK
    R = H // G
    q = partial_rope(rms_norm(split_heads(q, H), q_norm), positions) * (dh ** -0.5)
    k_s = partial_rope(rms_norm(split_heads(k_s, G), k_norm[1]), positions)
    k_w = partial_rope(rms_norm(split_heads(k_w, G), k_norm[2]), positions)
    v_s = split_heads(v_s, G)
    v_w = split_heads(v_w, G)

    n_cmp = (S - CMP_BLOCK) // CMP_STRIDE + 1
    cmp_idx = np.arange(n_cmp)[:, None] * CMP_STRIDE + np.arange(CMP_BLOCK)[None, :]
    cmp_end_np = cmp_idx[:, -1]
    raw = jnp.stack([split_heads(k_c, G), split_heads(v_c, G)])[:, :, :, cmp_idx]
    raw = (raw + cmp_pe[:, None, None, None]).reshape(2, B, G, n_cmp, CMP_BLOCK * dh)
    hid = jax.nn.gelu(jnp.einsum('kbgnf,kfe->kbgne', raw, cmp_w1))
    comp = jnp.einsum('kbgne,ked->kbgnd', hid, cmp_w2)
    k_cmp = partial_rope(rms_norm(comp[0], k_norm[0]), positions[:, cmp_end_np])
    v_cmp = comp[1]
    cmp_end = jnp.asarray(cmp_end_np, jnp.int32)

    n_blk = S // SEL_BLOCK
    c_start = np.arange(n_cmp) * CMP_STRIDE
    b_start = np.arange(n_blk) * SEL_BLOCK
    overlap = jnp.asarray(((c_start[:, None] < b_start[None, :] + SEL_BLOCK)
                           & (b_start[None, :] < c_start[:, None] + CMP_BLOCK)).astype(np.float32))
    n_sel = min(N_SEL, n_blk)
    ks_blk = k_s.reshape(B, G, n_blk, SEL_BLOCK, dh)
    vs_blk = v_s.reshape(B, G, n_blk, SEL_BLOCK, dh)
    kw_pad = jnp.pad(k_w, ((0, 0), (0, 0), (WINDOW, 0), (0, 0)))
    vw_pad = jnp.pad(v_w, ((0, 0), (0, 0), (WINDOW, 0), (0, 0)))

    n_qb = S // QB
    q_blocks = q.reshape(B, H, n_qb, QB, dh).transpose(2, 0, 1, 3, 4).reshape(n_qb, B, G, R, QB, dh)
    gates = jax.nn.sigmoid(gate_logits.astype(jnp.float32)).astype(q.dtype)
    g_blocks = (gates.reshape(B, S, H, 3).transpose(0, 2, 1, 3)
                .reshape(B, H, n_qb, QB, 3).transpose(2, 0, 1, 3, 4).reshape(n_qb, B, G, R, QB, 3))
    gather_blocks = jax.vmap(jax.vmap(lambda blk, ix: blk[ix]))
    blk_ids = jnp.arange(n_blk)

    def query_block(args):
        qi, qb, gb = args
        t = qi * QB + jnp.arange(QB)
        s_c = jnp.einsum('bgrqd,bgnd->bgrqn', qb, k_cmp)
        p_c = masked_softmax(s_c, cmp_end[None, :] <= t[:, None])
        o_c = jnp.einsum('bgrqn,bgnd->bgrqd', p_c.astype(v_cmp.dtype), v_cmp)
        imp = jnp.einsum('bgqn,nj->bgqj', jnp.sum(p_c, axis=2), overlap)
        causal = (blk_ids * SEL_BLOCK)[None, :] <= t[:, None]
        cur = (t // SEL_BLOCK)[:, None]
        forced = causal & ((blk_ids[None, :] == 0) | (blk_ids[None, :] == cur)
                           | (blk_ids[None, :] == cur - 1))
        score = jnp.where(forced, FORCE_SCORE, jnp.where(causal, imp, -FORCE_SCORE))
        _, idx = lax.top_k(score, n_sel)
        k_g = gather_blocks(ks_blk, idx)
        v_g = gather_blocks(vs_blk, idx)
        kpos = idx[..., None] * SEL_BLOCK + jnp.arange(SEL_BLOCK)
        mask_s = (kpos <= t[:, None, None])[:, :, None].reshape(B, G, 1, QB, n_sel * SEL_BLOCK)
        s_s = jnp.einsum('bgrqd,bgqnld->bgrqnl', qb, k_g).reshape(B, G, R, QB, n_sel * SEL_BLOCK)
        p_s = masked_softmax(s_s, mask_s).reshape(B, G, R, QB, n_sel, SEL_BLOCK)
        o_s = jnp.einsum('bgrqnl,bgqnld->bgrqd', p_s.astype(v_g.dtype), v_g)
        kwb = lax.dynamic_slice_in_dim(kw_pad, qi * QB, WINDOW + QB, axis=2)
        vwb = lax.dynamic_slice_in_dim(vw_pad, qi * QB, WINDOW + QB, axis=2)
        kp = qi * QB - WINDOW + jnp.arange(WINDOW + QB)
        mask_w = ((kp[None, :] <= t[:, None]) & (kp[None, :] > t[:, None] - WINDOW)
                  & (kp[None, :] >= 0))
        p_w = masked_softmax(jnp.einsum('bgrqd,bgkd->bgrqk', qb, kwb), mask_w)
        o_w = jnp.einsum('bgrqk,bgkd->bgrqd', p_w.astype(vwb.dtype), vwb)
        return gb[..., 0:1] * o_c + gb[..., 1:2] * o_s + gb[..., 2:3] * o_w

    out = lax.map(query_block, (jnp.arange(n_qb), q_blocks, g_blocks))
    return out.reshape(n_qb, B, H, QB, dh).transpose(1, 0, 3, 2, 4).reshape(B, S, H * dh)


def gated_linear_attention(q, k, v, r, g_low, w_gate, b_gate, norm_g):
    B, S, _ = q.shape
    H, C = GLA_HEADS, GLA_CHUNK
    n_c = S // C
    log_a = jax.nn.log_sigmoid((g_low @ w_gate + b_gate).astype(jnp.float32)) / GLA_TAU

    def chunks(t):
        return t.astype(jnp.float32).reshape(B, n_c, C, H, -1).transpose(1, 0, 3, 2, 4)

    qc = chunks(q) * (GLA_HEAD_DK ** -0.5)
    kc, vc, ac = chunks(k), chunks(v), chunks(log_a)
    tril = jnp.tril(jnp.ones((C, C), dtype=bool))

    def step(state, xs):
        qb, kb, vb, ab = xs
        b = jnp.cumsum(ab, axis=2)
        decay = jnp.exp(jnp.where(tril[:, :, None], b[:, :, :, None, :] - b[:, :, None, :, :], -jnp.inf))
        attn = jnp.einsum('bhid,bhjd,bhijd->bhij', qb, kb, decay)
        o = attn @ vb + jnp.einsum('bhid,bhdv->bhiv', qb * jnp.exp(b), state)
        b_last = b[:, :, -1:, :]
        state = (jnp.exp(b_last)[:, :, 0, :, None] * state
                 + jnp.einsum('bhjd,bhjv->bhdv', kb * jnp.exp(b_last - b), vb))
        return state, o

    state0 = jnp.zeros((B, H, GLA_HEAD_DK, GLA_HEAD_DV), jnp.float32)
    _, o = lax.scan(step, state0, (qc, kc, vc, ac))
    o = o.transpose(1, 0, 3, 2, 4).reshape(B, S, H, GLA_HEAD_DV)
    o = rms_norm(o, norm_g).reshape(B, S, H * GLA_HEAD_DV)
    return (o * jax.nn.silu(r.astype(jnp.float32))).astype(q.dtype)


def memory_attention(q, mem, mem_norm, w_kv, q_norm, k_norm):
    B, S, _ = q.shape
    H, dh = MEM_HEADS, MEM_HEAD_DIM
    k, v = jnp.split(rms_norm(mem, mem_norm) @ w_kv, 2, axis=-1)
    q = rms_norm(split_heads(q, H), q_norm) * (dh ** -0.5)
    k = rms_norm(split_heads(k, H), k_norm)
    v = split_heads(v, H)
    p = jax.nn.softmax(jnp.einsum('bhsd,bhmd->bhsm', q, k).astype(jnp.float32), axis=-1)
    o = jnp.einsum('bhsm,bhmd->bhsd', p.astype(v.dtype), v)
    return o.transpose(0, 2, 1, 3).reshape(B, S, H * dh)


def hybrid_layer(x, mem, positions, ln_mix, w_in, b_merge, nsa_q_norm, nsa_k_norm,
                 cmp_pe, cmp_w1, cmp_w2, gla_w_gate, gla_b_gate, gla_norm,
                 mem_norm, mem_w_kv, mem_q_norm, mem_k_norm, w_branch, w_out,
                 ln_mlp, w_up, w_down):
    B, S, D = x.shape
    h = rms_norm(x, ln_mix)
    z = h @ w_in
    offsets = np.cumsum(IN_SIZES)[:-1].tolist()
    (n_q, n_kc, n_vc, n_ks, n_vs, n_kw, n_vw, n_g,
     g_q, g_k, g_v, g_r, g_low, m_q, merge) = jnp.split(z, offsets, axis=-1)
    o_nsa = nsa_attention(n_q, n_kc, n_vc, n_ks, n_vs, n_kw, n_vw, n_g, positions,
                          nsa_q_norm, nsa_k_norm, cmp_pe, cmp_w1, cmp_w2)
    o_gla = gated_linear_attention(g_q, g_k, g_v, g_r, g_low, gla_w_gate, gla_b_gate, gla_norm)
    o_mem = memory_attention(m_q, mem, mem_norm, mem_w_kv, mem_q_norm, mem_k_norm)
    gates = jax.nn.sigmoid((merge.reshape(B, S, N_BRANCH, D) + b_merge).astype(jnp.float32)).astype(x.dtype)
    merged = (gates[:, :, 0] * (o_nsa @ w_branch[0])
              + gates[:, :, 1] * (o_gla @ w_branch[1])
              + gates[:, :, 2] * (o_mem @ w_branch[2]))
    x = x + merged @ w_out
    h = rms_norm(x, ln_mlp)
    return x + jnp.square(jax.nn.relu(h @ w_up)) @ w_down


def setup_inputs(seed: int = 0) -> dict:
    key = jax.random.key(seed)
    ks = jax.random.split(key, 24)
    f32 = jnp.float32
    dh = NSA_HEAD_DIM
    resid = (2 * DEPTH) ** -0.5

    def nrm(k, shape, scale):
        return jax.random.normal(k, shape, f32) * scale

    def gain(k, shape):
        return 1.0 + 0.02 * jax.random.normal(k, shape, f32)

    positions = (jnp.arange(SEQ, dtype=jnp.int32)[None, :]
                 + jax.random.randint(ks[2], (BATCH, 1), 0, SEQ, dtype=jnp.int32))
    return {
        'x': nrm(ks[0], (BATCH, SEQ, D_MODEL), 1.0),
        'mem': nrm(ks[1], (BATCH, MEM_LEN, D_MODEL), 1.0),
        'positions': positions,
        'ln_mix': gain(ks[3], (DEPTH, D_MODEL)),
        'w_in': nrm(ks[4], (DEPTH, D_MODEL, D_IN), D_MODEL ** -0.5),
        'b_merge': nrm(ks[5], (DEPTH, N_BRANCH, D_MODEL), 0.02),
        'nsa_q_norm': gain(ks[6], (DEPTH, dh)),
        'nsa_k_norm': gain(ks[7], (DEPTH, 3, dh)),
        'cmp_pe': nrm(ks[8], (DEPTH, 2, CMP_BLOCK, dh), 0.02),
        'cmp_w1': nrm(ks[9], (DEPTH, 2, CMP_BLOCK * dh, CMP_HIDDEN), (CMP_BLOCK * dh) ** -0.5),
        'cmp_w2': nrm(ks[10], (DEPTH, 2, CMP_HIDDEN, dh), CMP_HIDDEN ** -0.5),
        'gla_w_gate': nrm(ks[11], (DEPTH, GLA_RANK, GLA_HEADS * GLA_HEAD_DK), GLA_RANK ** -0.5),
        'gla_b_gate': nrm(ks[12], (DEPTH, GLA_HEADS * GLA_HEAD_DK), 0.02),
        'gla_norm': gain(ks[13], (DEPTH, GLA_HEAD_DV)),
        'mem_norm': gain(ks[14], (DEPTH, D_MODEL)),
        'mem_w_kv': nrm(ks[15], (DEPTH, D_MODEL, 2 * MEM_HEADS * MEM_HEAD_DIM), D_MODEL ** -0.5),
        'mem_q_norm': gain(ks[16], (DEPTH, MEM_HEAD_DIM)),
        'mem_k_norm': gain(ks[17], (DEPTH, MEM_HEAD_DIM)),
        'w_branch': nrm(ks[18], (DEPTH, N_BRANCH, BRANCH_WIDTH, D_MODEL), BRANCH_WIDTH ** -0.5),
        'w_out': nrm(ks[19], (DEPTH, D_MODEL, D_MODEL), D_MODEL ** -0.5 * resid),
        'ln_mlp': gain(ks[20], (DEPTH, D_MODEL)),
        'w_up': nrm(ks[21], (DEPTH, D_MODEL, MLP_HIDDEN), D_MODEL ** -0.5),
        'w_down': nrm(ks[22], (DEPTH, MLP_HIDDEN, D_MODEL), MLP_HIDDEN ** -0.5 * resid),
    }


def reference(x, mem, positions, ln_mix, w_in, b_merge, nsa_q_norm, nsa_k_norm,
              cmp_pe, cmp_w1, cmp_w2, gla_w_gate, gla_b_gate, gla_norm,
              mem_norm, mem_w_kv, mem_q_norm, mem_k_norm, w_branch, w_out,
              ln_mlp, w_up, w_down):
    for l in range(DEPTH):
        x = hybrid_layer(x, mem, positions, ln_mix[l], w_in[l], b_merge[l],
                         nsa_q_norm[l], nsa_k_norm[l], cmp_pe[l], cmp_w1[l], cmp_w2[l],
                         gla_w_gate[l], gla_b_gate[l], gla_norm[l],
                         mem_norm[l], mem_w_kv[l], mem_q_norm[l], mem_k_norm[l],
                         w_branch[l], w_out[l], ln_mlp[l], w_up[l], w_down[l])
    return x
```

```cpp
#include <hip/hip_runtime.h>
#include <hip/hip_cooperative_groups.h>
#include <cstdio>
#include <cmath>
namespace cg = cooperative_groups;
#define LAS __attribute__((address_space(3)))
typedef unsigned short bf16_t;
typedef short bf16x8 __attribute__((ext_vector_type(8)));
typedef short bf16x4 __attribute__((ext_vector_type(4)));
typedef float f32x4 __attribute__((ext_vector_type(4)));
typedef unsigned u32x4 __attribute__((ext_vector_type(4)));
typedef unsigned u32x2 __attribute__((ext_vector_type(2)));
typedef unsigned long long u64;

constexpr int NB = 8, SEQ = 4096, DM = 1024, NT = NB * SEQ, DEPTH = 4, DIN = 6440, NIN = 6656;
constexpr size_t MiB = 1048576;
constexpr size_t WS_CTL = 0;
constexpr size_t WS_ROPE = 4096;
constexpr size_t WS_WIN = WS_ROPE + 2 * MiB;
constexpr size_t WS_WBR = WS_WIN + 13 * MiB;
constexpr size_t WS_WOUT = WS_WBR + 3 * MiB;
constexpr size_t WS_WUP = WS_WOUT + 2 * MiB;
constexpr size_t WS_WDN = WS_WUP + 8 * MiB;
constexpr size_t WS_WKV = WS_WDN + 8 * MiB;
constexpr size_t WS_W1 = WS_WKV + 2 * MiB;
constexpr size_t WS_B1 = WS_W1 + 2 * MiB;
constexpr size_t WS_H = WS_B1 + 4096;
constexpr size_t WS_HM = WS_H + 64 * MiB;
constexpr size_t WS_QN = WS_HM + 4 * MiB;
constexpr size_t WS_KC = WS_QN + 32 * MiB;
constexpr size_t WS_VC = WS_KC + 8 * MiB;
constexpr size_t WS_KS = WS_VC + 8 * MiB;
constexpr size_t WS_KW = WS_KS + 8 * MiB;
constexpr size_t WS_VS = WS_KW + 8 * MiB;
constexpr size_t WS_VW = WS_VS + 8 * MiB;
constexpr size_t WS_VTS = WS_VW + 8 * MiB;
constexpr size_t WS_VTW = WS_VTS + 8 * MiB;
constexpr size_t WS_GQ = WS_VTW + 8 * MiB;
constexpr size_t WS_GK = WS_GQ + 16 * MiB;
constexpr size_t WS_GV = WS_GK + 16 * MiB;
constexpr size_t WS_GR = WS_GV + 32 * MiB;
constexpr size_t WS_MQ = WS_GR + 32 * MiB;
constexpr size_t WS_SM = WS_MQ + 32 * MiB;
constexpr size_t WS_G = WS_SM + 5 * MiB;
constexpr size_t WS_HID = WS_G + 96 * MiB;
constexpr size_t WS_KCMP = WS_HID + 4 * MiB;
constexpr size_t WS_VCMPT = WS_KCMP + MiB / 2;
constexpr size_t WS_MKV = WS_VCMPT + MiB / 2;
constexpr size_t WS_MK = WS_MKV + 4 * MiB;
constexpr size_t WS_MVT = WS_MK + 2 * MiB;
constexpr size_t WS_END = WS_MVT + 2 * MiB;
constexpr size_t WS_MERGED = WS_KC;
constexpr size_t WS_U = WS_QN;
constexpr int LDS_BYTES = 131072;

__device__ __forceinline__ float bf2f(bf16_t b) { return __uint_as_float(((unsigned)b) << 16); }
__device__ __forceinline__ bf16_t f2bf(float f) { unsigned u = __float_as_uint(f); u += 0x7FFFu + ((u >> 16) & 1u); return (bf16_t)(u >> 16); }
__device__ __forceinline__ unsigned pk2(float lo, float hi) { return (unsigned)f2bf(lo) | ((unsigned)f2bf(hi) << 16); }
__device__ __forceinline__ float sigmoidf_(float x) { return 1.0f / (1.0f + __expf(-x)); }

__device__ __forceinline__ int opq_tid() { int t = threadIdx.x; asm volatile("" : "+v"(t)); return t; }
__device__ __forceinline__ int opq_bid() { int t = blockIdx.x; asm volatile("" : "+s"(t)); return t; }
__device__ __forceinline__ int opq_gdim() { int t = gridDim.x; asm volatile("" : "+s"(t)); return t; }
namespace pg8 {
constexpr int BM = 256, BK = 64, HALF = 128, HTB = HALF * BK * 2, STAGE_BYTES = 8 * HTB, NXCD = 8, WGM = 8;
__host__ __device__ __forceinline__ int lds_byte(int r, int c) { const int st = (r >> 4) * 2 + (c >> 5), rr = r & 15, cc = c & 31, ob = rr * 64 + cc * 2; return st * 1024 + (ob ^ (((ob >> 9) & 1) << 5)); }
__host__ __device__ __forceinline__ void stage_rc(int b, int& R, int& C) { const int st = b / 1024, sb = b % 1024, swz = sb ^ (((sb >> 9) & 1) << 5); R = (st >> 1) * 16 + swz / 64; C = (st & 1) * 32 + (swz % 64) / 2; }
__host__ __device__ __forceinline__ int perm32(int rho) { const int n = rho >> 4, i = rho & 15; return 8 * (i >> 2) + 4 * n + (i & 3); }
struct Unit { int pm, pn; };
struct Gemm { const bf16_t* A; const bf16_t* Bt; int M, N, K, lda, ldb; };
struct StaticOrder {
    int nM, nN, nwg, G, c;
    __device__ void init(int M, int N, int G_, int c_) { asm volatile("" : "+s"(c_), "+s"(G_)); nM = M / BM; nN = N / BM; nwg = nM * nN; G = G_; c = c_; }
    __device__ bool next(int i, Unit& u) const {
        if (c < 0) return false;
        const long L = (long)i * G + c; if (L >= nwg) return false;
        int wgid = (int)L; { const int q = nwg / NXCD, r = nwg % NXCD, xcd = wgid % NXCD, off = wgid / NXCD; wgid = (xcd < r ? xcd * (q + 1) : r * (q + 1) + (xcd - r) * q) + off; }
        const int nig = WGM * nN, gid = wgid / nig, fm = gid * WGM, gsz = (nM - fm) < WGM ? (nM - fm) : WGM;
        u.pm = fm + ((wgid % nig) % gsz); u.pn = (wgid % nig) / gsz; return true;
    }
    __device__ __forceinline__ void a_ready(const Unit&) const {}
    __device__ __forceinline__ void done(const Unit&) const {}
};

template <class Epi, class Sched>
__device__ __forceinline__ void gemm_phase(LAS unsigned char* lds, const Gemm g, const Sched& S, const Epi& E) {
    int tid = threadIdx.x; asm volatile("" : "+v"(tid));
    const int wid = __builtin_amdgcn_readfirstlane(tid >> 6), lane = tid & 63, wr = wid >> 2, wc = wid & 3, fr = lane & 15, fq = lane >> 4;
    int K = g.K; asm volatile("" : "+s"(K)); const int nt = K / BK;
    unsigned voffA[2], voffB[2];
#pragma unroll
    for (int i = 0; i < 2; ++i) { int R, C; stage_rc(tid * 16 + i * 8192, R, C); const int Rb = Epi::PERM ? ((R & ~31) + perm32(R & 31)) : R;
        voffA[i] = (unsigned)(R * g.lda + C) * 2u; voffB[i] = (unsigned)(Rb * g.ldb + C) * 2u; }
    const size_t kstep = (size_t)(BK * 2);
    const size_t hstepA = (size_t)HALF * g.lda * 2, hstepB = (size_t)HALF * g.ldb * 2;
    const size_t tstepA = 2 * hstepA, tstepB = 2 * hstepB;
    const unsigned ldsw = (unsigned)wid * 1024u;
    const int aoff = lds_byte(wr * 64 + fr, fq * 8), boff = lds_byte(wc * 32 + fr, fq * 8);
#define PG8_SA(b, h) (((b) * 2 + (h)) * HTB)
#define PG8_SB(b, h) ((4 + (b) * 2 + (h)) * HTB)
#define PG8_STAGE(bufoff, gbase, voff) do { _Pragma("unroll") for (int _i = 0; _i < 2; ++_i) \
        __builtin_amdgcn_global_load_lds((const unsigned*)((const char*)(gbase) + (voff)[_i]), (LAS unsigned*)(lds + (bufoff) + ldsw + _i * 8192), 16, 0, 0); } while (0)
#define PG8_LDA(dst, b, h) do { _Pragma("unroll") for (int m = 0; m < 4; ++m) _Pragma("unroll") for (int k = 0; k < 2; ++k) dst[m][k] = *(const LAS bf16x8*)(lds + PG8_SA(b, h) + aoff + m * 2048 + k * 1024); } while (0)
#define PG8_LDB(dst, b, h) do { _Pragma("unroll") for (int n = 0; n < 2; ++n) _Pragma("unroll") for (int k = 0; k < 2; ++k) dst[n][k] = *(const LAS bf16x8*)(lds + PG8_SB(b, h) + boff + n * 2048 + k * 1024); } while (0)
#define PG8_MMA(ai, bj, At, Bt) do { __builtin_amdgcn_s_setprio(1); _Pragma("unroll") for (int m = 0; m < 4; ++m) _Pragma("unroll") for (int n = 0; n < 2; ++n) _Pragma("unroll") for (int k = 0; k < 2; ++k) \
        acc[ai][bj][m][n] = __builtin_amdgcn_mfma_f32_16x16x32_bf16(Bt[n][k], At[m][k], acc[ai][bj][m][n], 0, 0, 0); __builtin_amdgcn_s_setprio(0); } while (0)
#define PG8_WAIT_V(n) asm volatile("s_waitcnt vmcnt(" #n ")" ::: "memory")
#define PG8_WAIT_L(n) asm volatile("s_waitcnt lgkmcnt(" #n ")" ::: "memory")
#define PG8_BAR __builtin_amdgcn_s_barrier()
#define PG8_SCHED __builtin_amdgcn_sched_barrier(0)
    Unit cur, nxt; int ui = 0;
    if (!S.next(0, cur)) return;
    f32x4 acc[2][2][4][2];
#pragma unroll
    for (int a = 0; a < 2; ++a)
#pragma unroll
        for (int b = 0; b < 2; ++b)
#pragma unroll
            for (int m = 0; m < 4; ++m)
#pragma unroll
                for (int n = 0; n < 2; ++n) acc[a][b][m][n] = (f32x4){0.f, 0.f, 0.f, 0.f};
    bf16x8 At[4][2], B0[2][2], B1[2][2];
    const char* cA = (const char*)g.A + (size_t)cur.pm * tstepA; const char* cB = (const char*)g.Bt + (size_t)cur.pn * tstepB;
    S.a_ready(cur);
    PG8_STAGE(PG8_SB(0, 0), cB, voffB); PG8_STAGE(PG8_SA(0, 0), cA, voffA); PG8_STAGE(PG8_SB(0, 1), cB + hstepB, voffB); PG8_STAGE(PG8_SA(0, 1), cA + hstepA, voffA);
    if (wr == 1) PG8_BAR;
    PG8_WAIT_V(4); PG8_BAR;
    PG8_STAGE(PG8_SB(1, 0), cB + kstep, voffB); PG8_STAGE(PG8_SA(1, 0), cA + kstep, voffA); PG8_STAGE(PG8_SB(1, 1), cB + hstepB + kstep, voffB);
    PG8_WAIT_V(6); PG8_BAR;
    for (;;) {
        const bool has_next = S.next(ui + 1, nxt);
        const char* nA = has_next ? (const char*)g.A + (size_t)nxt.pm * tstepA : cA; const char* nB = has_next ? (const char*)g.Bt + (size_t)nxt.pn * tstepB : cB;
        for (int t = 0; t < nt; t += 2) {
            const bool last = (t == nt - 2);
            const char* a1 = cA + (size_t)(t + 1) * kstep;
            const char* a2 = last ? nA : cA + (size_t)(t + 2) * kstep; const char* b2 = last ? nB : cB + (size_t)(t + 2) * kstep;
            const char* a3 = a2 + kstep; const char* b3 = b2 + kstep;
            if (last && has_next) S.a_ready(nxt);
            PG8_LDB(B0, 0, 0); PG8_SCHED; PG8_LDA(At, 0, 0); PG8_STAGE(PG8_SA(1, 1), a1 + hstepA, voffA);
            PG8_WAIT_L(8); PG8_BAR; PG8_WAIT_L(0); PG8_MMA(0, 0, At, B0); PG8_BAR; PG8_SCHED;
            PG8_LDB(B1, 0, 1); PG8_STAGE(PG8_SB(0, 0), b2, voffB);
            PG8_BAR; PG8_WAIT_L(0); PG8_MMA(0, 1, At, B1); PG8_BAR;
            PG8_LDA(At, 0, 1); PG8_STAGE(PG8_SA(0, 0), a2, voffA);
            PG8_BAR; PG8_WAIT_L(0); PG8_MMA(1, 0, At, B0); PG8_BAR; PG8_SCHED;
            PG8_STAGE(PG8_SB(0, 1), b2 + hstepB, voffB);
            PG8_WAIT_V(6); PG8_BAR; PG8_MMA(1, 1, At, B1); PG8_BAR;
            PG8_LDB(B0, 1, 0); PG8_SCHED; PG8_LDA(At, 1, 0); PG8_STAGE(PG8_SA(0, 1), a2 + hstepA, voffA);
            PG8_WAIT_L(8); PG8_BAR; PG8_WAIT_L(0); PG8_MMA(0, 0, At, B0); PG8_BAR; PG8_SCHED;
            PG8_LDB(B1, 1, 1); PG8_STAGE(PG8_SB(1, 0), b3, voffB);
            PG8_BAR; PG8_WAIT_L(0); PG8_MMA(0, 1, At, B1); PG8_BAR;
            PG8_LDA(At, 1, 1); PG8_STAGE(PG8_SA(1, 0), a3, voffA);
            PG8_BAR; PG8_WAIT_L(0); PG8_MMA(1, 0, At, B0); PG8_BAR; PG8_SCHED;
            PG8_STAGE(PG8_SB(1, 1), b3 + hstepB, voffB);
            PG8_WAIT_V(6); PG8_BAR; PG8_MMA(1, 1, At, B1); PG8_BAR;
        }
        E(acc, cur, wr, wc, fr, fq); S.done(cur);
        if (!has_next) break;
#pragma unroll
        for (int a = 0; a < 2; ++a)
#pragma unroll
            for (int b = 0; b < 2; ++b)
#pragma unroll
                for (int m = 0; m < 4; ++m)
#pragma unroll
                    for (int n = 0; n < 2; ++n) acc[a][b][m][n] = (f32x4){0.f, 0.f, 0.f, 0.f};
        cur = nxt; cA = nA; cB = nB; ++ui;
    }
    PG8_WAIT_V(0);
    if (wr == 0) PG8_BAR;
    PG8_BAR;
#undef PG8_SA
#undef PG8_SB
#undef PG8_STAGE
#undef PG8_LDA
#undef PG8_LDB
#undef PG8_MMA
#undef PG8_WAIT_V
#undef PG8_WAIT_L
#undef PG8_BAR
#undef PG8_SCHED
}
}
using pg8::Unit; using pg8::Gemm; using pg8::StaticOrder; using pg8::gemm_phase; using pg8::HALF; using pg8::BM;
#define EPI_LOOP_ROWS for (int ai = 0; ai < 2; ++ai) for (int m = 0; m < 4; ++m)
__device__ __forceinline__ u32x4 pack8(const f32x4 a, const f32x4 b) { u32x4 w; w.x = pk2(a[0], a[1]); w.y = pk2(a[2], a[3]); w.z = pk2(b[0], b[1]); w.w = pk2(b[2], b[3]); return w; }

struct EpiInProj {
    static constexpr bool PERM = true;
    unsigned char* ws;
    __device__ __forceinline__ void operator()(const f32x4 (&acc)[2][2][4][2], const Unit& u, int wr, int wc, int fr, int fq) const {
        const int pn = u.pn;
#pragma unroll
        for (int ai = 0; ai < 2; ++ai)
#pragma unroll
            for (int m = 0; m < 4; ++m) {
                const int tok = u.pm * BM + ai * HALF + wr * 64 + m * 16 + fr; const int b = tok >> 12, t = tok & 4095;
#pragma unroll
                for (int bj = 0; bj < 2; ++bj) {
                    const int cb = bj * HALF + wc * 32 + 8 * fq;
                    const f32x4 v0 = acc[ai][bj][m][0], v1 = acc[ai][bj][m][1];
                    if (pn == 13) { if (cb < 40) { float* p = (float*)(ws + WS_SM) + (size_t)tok * 40 + cb; *(f32x4*)p = v0; *(f32x4*)(p + 4) = v1; } continue; }
                    bf16_t* dst;
                    if (pn <= 1) dst = (bf16_t*)(ws + WS_QN) + (size_t)tok * 512 + pn * 256 + cb;
                    else if (pn <= 4) { const int which = (pn - 2) * 2 + (cb >> 7);
                        const size_t base = which == 0 ? WS_KC : which == 1 ? WS_VC : which == 2 ? WS_KS : which == 3 ? WS_VS : which == 4 ? WS_KW : WS_VW;
                        const int c = cb & 127, g = c >> 6, d = c & 63;
                        dst = (bf16_t*)(ws + base) + ((size_t)(b * 2 + g) * SEQ + t) * 64 + d; }
                    else if (pn <= 6) { const int h = cb >> 6, d = cb & 63; dst = (bf16_t*)(ws + (pn == 5 ? WS_GQ : WS_GK)) + ((size_t)(b * 4 + h) * SEQ + t) * 64 + d; }
                    else if (pn <= 8) { const int c = (pn - 7) * 256 + cb, h = c >> 7, d = c & 127; dst = (bf16_t*)(ws + WS_GV) + ((size_t)(b * 4 + h) * SEQ + t) * 128 + d; }
                    else if (pn <= 10) dst = (bf16_t*)(ws + WS_GR) + (size_t)tok * 512 + (pn - 9) * 256 + cb;
                    else dst = (bf16_t*)(ws + WS_MQ) + (size_t)tok * 512 + (pn - 11) * 256 + cb;
                    *(u32x4*)dst = pack8(v0, v1);
                    asm volatile("" ::: "memory");
                }
            }
    }
};
struct EpiGates {
    static constexpr bool PERM = true;
    bf16_t* G; const float* bias;
    __device__ __forceinline__ void operator()(const f32x4 (&acc)[2][2][4][2], const Unit& u, int wr, int wc, int fr, int fq) const {
#pragma unroll
        for (int bj = 0; bj < 2; ++bj) {
            const int col = u.pn * BM + bj * HALF + wc * 32 + 8 * fq;
            const f32x4 b0 = *(const f32x4*)(bias + col), b1 = *(const f32x4*)(bias + col + 4);
#pragma unroll
            for (int ai = 0; ai < 2; ++ai)
#pragma unroll
                for (int m = 0; m < 4; ++m) {
                    const int row = u.pm * BM + ai * HALF + wr * 64 + m * 16 + fr;
                    f32x4 v0 = acc[ai][bj][m][0] + b0, v1 = acc[ai][bj][m][1] + b1;
#pragma unroll
                    for (int j = 0; j < 4; ++j) { v0[j] = sigmoidf_(v0[j]); v1[j] = sigmoidf_(v1[j]); }
                    *(u32x4*)(G + (size_t)row * 3072 + col) = pack8(v0, v1); asm volatile("" ::: "memory");
                }
        }
    }
};
template <int MODE> struct EpiMerge {
    static constexpr bool PERM = true;
    bf16_t* merged; const bf16_t* G; int br;
    __device__ __forceinline__ void operator()(const f32x4 (&acc)[2][2][4][2], const Unit& u, int wr, int wc, int fr, int fq) const {
#pragma unroll
        for (int ai = 0; ai < 2; ++ai)
#pragma unroll
            for (int m = 0; m < 4; ++m) {
                const int row = u.pm * BM + ai * HALF + wr * 64 + m * 16 + fr;
#pragma unroll
                for (int bj = 0; bj < 2; ++bj) {
                    const int col = u.pn * BM + bj * HALF + wc * 32 + 8 * fq;
                    const u32x4 gv = *(const u32x4*)(G + (size_t)row * 3072 + br * 1024 + col);
                    bf16_t* mp = merged + (size_t)row * 1024 + col;
                    f32x4 v0 = acc[ai][bj][m][0], v1 = acc[ai][bj][m][1];
                    v0[0] *= __uint_as_float(gv.x << 16); v0[1] *= __uint_as_float(gv.x & 0xffff0000u); v0[2] *= __uint_as_float(gv.y << 16); v0[3] *= __uint_as_float(gv.y & 0xffff0000u);
                    v1[0] *= __uint_as_float(gv.z << 16); v1[1] *= __uint_as_float(gv.z & 0xffff0000u); v1[2] *= __uint_as_float(gv.w << 16); v1[3] *= __uint_as_float(gv.w & 0xffff0000u);
                    if (MODE == 1) { const u32x4 o = *(const u32x4*)mp;
                        v0[0] += __uint_as_float(o.x << 16); v0[1] += __uint_as_float(o.x & 0xffff0000u); v0[2] += __uint_as_float(o.y << 16); v0[3] += __uint_as_float(o.y & 0xffff0000u);
                        v1[0] += __uint_as_float(o.z << 16); v1[1] += __uint_as_float(o.z & 0xffff0000u); v1[2] += __uint_as_float(o.w << 16); v1[3] += __uint_as_float(o.w & 0xffff0000u); }
                    *(u32x4*)mp = pack8(v0, v1); asm volatile("" ::: "memory");
                }
            }
    }
};
struct EpiResid {
    static constexpr bool PERM = false;
    const float* base; float* out;
    __device__ __forceinline__ void operator()(const f32x4 (&acc)[2][2][4][2], const Unit& u, int wr, int wc, int fr, int fq) const {
#pragma unroll
        for (int ai = 0; ai < 2; ++ai)
#pragma unroll
            for (int m = 0; m < 4; ++m) {
                const size_t off = (size_t)(u.pm * BM + ai * HALF + wr * 64 + m * 16 + fr) * 1024 + u.pn * BM + wc * 32 + 4 * fq;
#pragma unroll
                for (int bj = 0; bj < 2; ++bj)
#pragma unroll
                    for (int n = 0; n < 2; ++n) { const f32x4 bs = *(const f32x4*)(base + off + bj * HALF + n * 16); *(f32x4*)(out + off + bj * HALF + n * 16) = bs + acc[ai][bj][m][n]; }
            }
    }
};
struct EpiRelu2 {
    static constexpr bool PERM = true;
    bf16_t* U;
    __device__ __forceinline__ void operator()(const f32x4 (&acc)[2][2][4][2], const Unit& u, int wr, int wc, int fr, int fq) const {
#pragma unroll
        for (int ai = 0; ai < 2; ++ai)
#pragma unroll
            for (int m = 0; m < 4; ++m) {
                const int row = u.pm * BM + ai * HALF + wr * 64 + m * 16 + fr;
#pragma unroll
                for (int bj = 0; bj < 2; ++bj) {
                    const int col = u.pn * BM + bj * HALF + wc * 32 + 8 * fq;
                    f32x4 v0 = acc[ai][bj][m][0], v1 = acc[ai][bj][m][1];
#pragma unroll
                    for (int j = 0; j < 4; ++j) { const float a = fmaxf(v0[j], 0.f), b = fmaxf(v1[j], 0.f); v0[j] = a * a; v1[j] = b * b; }
                    *(u32x4*)(U + (size_t)row * 4096 + col) = pack8(v0, v1); asm volatile("" ::: "memory");
                }
            }
    }
};
__device__ __forceinline__ float gelu_tanh(float x) { const float y = 0.7978845608028654f * (x + 0.044715f * x * x * x); const float e = __expf(2.0f * y); const float th = 1.0f - 2.0f / (e + 1.0f); return 0.5f * x * (1.0f + th); }
struct EpiHid {
    static constexpr bool PERM = true;
    bf16_t* O; const float* bias;
    __device__ __forceinline__ void operator()(const f32x4 (&acc)[2][2][4][2], const Unit& u, int wr, int wc, int fr, int fq) const {
#pragma unroll
        for (int bj = 0; bj < 2; ++bj) {
            const int col = bj * HALF + wc * 32 + 8 * fq;
            const f32x4 b0 = *(const f32x4*)(bias + col), b1 = *(const f32x4*)(bias + col + 4);
#pragma unroll
            for (int ai = 0; ai < 2; ++ai)
#pragma unroll
                for (int m = 0; m < 4; ++m) {
                    const int row = u.pm * BM + ai * HALF + wr * 64 + m * 16 + fr;
                    f32x4 v0 = acc[ai][bj][m][0] + b0, v1 = acc[ai][bj][m][1] + b1;
#pragma unroll
                    for (int j = 0; j < 4; ++j) { v0[j] = gelu_tanh(v0[j]); v1[j] = gelu_tanh(v1[j]); }
                    *(u32x4*)(O + (size_t)row * 256 + col) = pack8(v0, v1); asm volatile("" ::: "memory");
                }
        }
    }
};
struct EpiPlain {
    static constexpr bool PERM = true;
    bf16_t* O; int ldc;
    __device__ __forceinline__ void operator()(const f32x4 (&acc)[2][2][4][2], const Unit& u, int wr, int wc, int fr, int fq) const {
#pragma unroll
        for (int ai = 0; ai < 2; ++ai)
#pragma unroll
            for (int m = 0; m < 4; ++m) {
                const int row = u.pm * BM + ai * HALF + wr * 64 + m * 16 + fr;
#pragma unroll
                for (int bj = 0; bj < 2; ++bj) { const int col = u.pn * BM + bj * HALF + wc * 32 + 8 * fq; *(u32x4*)(O + (size_t)row * ldc + col) = pack8(acc[ai][bj][m][0], acc[ai][bj][m][1]); }
            }
    }
};
struct Params {
    const float* in[23];
    float* out; unsigned char* ws;
    float inv_freq[8];
};
enum { I_X = 0, I_MEM, I_POS, I_LN_MIX, I_W_IN, I_B_MERGE, I_NQ_NORM, I_NK_NORM, I_CMP_PE, I_CMP_W1, I_CMP_W2, I_GLA_WG, I_GLA_BG, I_GLA_NORM,
       I_MEM_NORM, I_MEM_WKV, I_MEM_QN, I_MEM_KN, I_W_BRANCH, I_W_OUT, I_LN_MLP, I_W_UP, I_W_DOWN };

__device__ __forceinline__ int win_src_col(int n) {
    if (n < 1280) return n;
    if (n < 2816) return n + 24;
    if (n < 3328) return n + 40;
    if (n < 3352) return 1280 + (n - 3328);
    if (n < 3368) return 2840 + (n - 3352);
    if (n < 3584) return -1;
    return n - 216;
}
__device__ __forceinline__ void conv_tile(const float* __restrict__ src, int ldsrc, bf16_t* __restrict__ dst, int K, int n0, int k0, bool winmap, LAS float* tile) {
    const int tid = opq_tid();
    { const int n = tid & 63; const int sc = winmap ? win_src_col(n0 + n) : (n0 + n);
#pragma unroll
      for (int i = 0; i < 8; ++i) { const int k = (tid >> 6) + 8 * i; tile[k * 65 + n] = sc >= 0 ? src[(size_t)(k0 + k) * ldsrc + sc] : 0.f; } }
    __syncthreads();
    { const int k2 = (tid & 31) * 2;
#pragma unroll
      for (int i = 0; i < 4; ++i) { const int n2 = (tid >> 5) + 16 * i; *(unsigned*)(dst + (size_t)(n0 + n2) * K + k0 + k2) = pk2(tile[k2 * 65 + n2], tile[(k2 + 1) * 65 + n2]); } }
    __syncthreads();
}
__device__ void phase_convert(const Params& p, int l, LAS unsigned char* lds) {
    asm volatile("" : "+s"(l));
    LAS float* tile = (LAS float*)lds;
    unsigned char* ws = p.ws;
    for (int it = opq_bid(); it < 4864; it += opq_gdim()) {
        int i = it; const float* src; bf16_t* dst; int K, ld, ntn; bool wm = false;
        if (i < 1664) { src = p.in[I_W_IN] + (size_t)l * 1024 * DIN; dst = (bf16_t*)(ws + WS_WIN); K = 1024; ld = DIN; ntn = 104; wm = true; }
        else if ((i -= 1664) < 384) { const int br = i / 128; i -= br * 128; src = p.in[I_W_BRANCH] + ((size_t)l * 3 + br) * 512 * 1024; dst = (bf16_t*)(ws + WS_WBR) + (size_t)br * 1024 * 512; K = 512; ld = 1024; ntn = 16; }
        else if ((i -= 384) < 256) { src = p.in[I_W_OUT] + (size_t)l * 1024 * 1024; dst = (bf16_t*)(ws + WS_WOUT); K = 1024; ld = 1024; ntn = 16; }
        else if ((i -= 256) < 1024) { src = p.in[I_W_UP] + (size_t)l * 1024 * 4096; dst = (bf16_t*)(ws + WS_WUP); K = 1024; ld = 4096; ntn = 64; }
        else if ((i -= 1024) < 1024) { src = p.in[I_W_DOWN] + (size_t)l * 4096 * 1024; dst = (bf16_t*)(ws + WS_WDN); K = 4096; ld = 1024; ntn = 16; }
        else if ((i -= 1024) < 256) { src = p.in[I_MEM_WKV] + (size_t)l * 1024 * 1024; dst = (bf16_t*)(ws + WS_WKV); K = 1024; ld = 1024; ntn = 16; }
        else { i -= 256; const int kv = i / 128; i -= kv * 128; src = p.in[I_CMP_W1] + ((size_t)l * 2 + kv) * 2048 * 256; dst = (bf16_t*)(ws + WS_W1) + (size_t)kv * 256 * 2048; K = 2048; ld = 256; ntn = 4; }
        const int tn = i % ntn, tk = i / ntn;
        conv_tile(src, ld, dst, K, tn * 64, tk * 64, wm, tile);
    }
}
__device__ void phase_bias1(const Params& p, int l, LAS unsigned char* lds) {
    asm volatile("" : "+s"(l));
    if (opq_bid() < opq_gdim() - 8) return;
    const int j = opq_bid() - (opq_gdim() - 8), kv = j >> 2, e0 = (j & 3) * 64;
    const int tid = opq_tid(), w = tid >> 6, lane = tid & 63;
    const float* pe = p.in[I_CMP_PE] + ((size_t)l * 2 + kv) * 2048; const float* W1 = p.in[I_CMP_W1] + ((size_t)l * 2 + kv) * 2048 * 256;
    float s = 0.f;
    for (int f = w * 256; f < w * 256 + 256; ++f) s += pe[f] * W1[(size_t)f * 256 + e0 + lane];
    LAS float* red = (LAS float*)lds;
    __syncthreads(); red[w * 64 + lane] = s; __syncthreads();
    if (w == 0) { float t = 0.f; for (int i = 0; i < 8; ++i) t += red[i * 64 + lane]; ((float*)(p.ws + WS_B1))[kv * 256 + e0 + lane] = t; }
    __syncthreads();
}
__device__ __forceinline__ float wave_sum(float v) {
#pragma unroll
    for (int o = 32; o >= 1; o >>= 1) v += __shfl_xor(v, o);
    return v;
}
__device__ void phase_rmsnorm(const float* __restrict__ x, const float* __restrict__ g, bf16_t* __restrict__ out, int nrows) {
    const int lane = opq_tid() & 63; const int gw = opq_bid() * 8 + (opq_tid() >> 6), nw = opq_gdim() * 8;
    f32x4 gg[4];
#pragma unroll
    for (int i = 0; i < 4; ++i) gg[i] = ((const f32x4*)g)[lane + 64 * i];
    for (int r = gw; r < nrows; r += nw) {
        const f32x4* xr = (const f32x4*)(x + (size_t)r * 1024); f32x4 v[4]; float ss = 0.f;
#pragma unroll
        for (int i = 0; i < 4; ++i) { v[i] = xr[lane + 64 * i]; ss += v[i][0] * v[i][0] + v[i][1] * v[i][1] + v[i][2] * v[i][2] + v[i][3] * v[i][3]; }
        ss = wave_sum(ss); const float rstd = 1.0f / sqrtf(ss * (1.0f / 1024.0f) + 1e-6f);
#pragma unroll
        for (int i = 0; i < 4; ++i) { u32x2 w; w.x = pk2(v[i][0] * rstd * gg[i][0], v[i][1] * rstd * gg[i][1]); w.y = pk2(v[i][2] * rstd * gg[i][2], v[i][3] * rstd * gg[i][3]);
            *(u32x2*)(out + (size_t)r * 1024 + (lane + 64 * i) * 4) = w; }
    }
}
__device__ void phase_rope_table(const Params& p) {
    float* tab = (float*)(p.ws + WS_ROPE); const int* pos = (const int*)p.in[I_POS];
    for (int i = opq_bid() * 512 + opq_tid(); i < NT * 8; i += opq_gdim() * 512) {
        const int tok = i >> 3, f = i & 7;
        float ifr = 0.f;
#pragma unroll
        for (int k = 0; k < 8; ++k) if (f == k) ifr = p.inv_freq[k];
        const float angf = (float)pos[tok] * ifr;
        double a = (double)angf; a -= 6.283185307179586 * rint(a * 0.15915494309189535);
        const float r = (float)a; tab[tok * 16 + f] = cosf(r); tab[tok * 16 + 8 + f] = sinf(r);
    }
}
template <bool PAIR, bool ROPE>
__device__ __forceinline__ void norm_vec64(bf16_t* ptr, const float* __restrict__ gain, const float* __restrict__ rt, float scale) {
    u32x4 raw[8]; float x[64];
#pragma unroll
    for (int i = 0; i < 8; ++i) raw[i] = ((const u32x4*)ptr)[i];
    float ss = 0.f;
#pragma unroll
    for (int i = 0; i < 8; ++i) {
        x[i * 8 + 0] = __uint_as_float(raw[i].x << 16); x[i * 8 + 1] = __uint_as_float(raw[i].x & 0xffff0000u);
        x[i * 8 + 2] = __uint_as_float(raw[i].y << 16); x[i * 8 + 3] = __uint_as_float(raw[i].y & 0xffff0000u);
        x[i * 8 + 4] = __uint_as_float(raw[i].z << 16); x[i * 8 + 5] = __uint_as_float(raw[i].z & 0xffff0000u);
        x[i * 8 + 6] = __uint_as_float(raw[i].w << 16); x[i * 8 + 7] = __uint_as_float(raw[i].w & 0xffff0000u);
    }
#pragma unroll
    for (int i = 0; i < 64; ++i) ss += x[i] * x[i];
    if (PAIR) ss += __shfl_xor(ss, 1);
    const float rstd = 1.0f / sqrtf(ss * (PAIR ? (1.0f / 128.0f) : (1.0f / 64.0f)) + 1e-6f);
#pragma unroll
    for (int i = 0; i < 64; ++i) x[i] = x[i] * rstd * gain[i];
    if (ROPE) {
#pragma unroll
        for (int i = 0; i < 8; ++i) { const float c = rt[i], s = rt[8 + i]; const float a = x[i], b = x[i + 8]; x[i] = a * c - b * s; x[i + 8] = b * c + a * s; }
    }
#pragma unroll
    for (int i = 0; i < 8; ++i) { u32x4 w; w.x = pk2(x[i * 8] * scale, x[i * 8 + 1] * scale); w.y = pk2(x[i * 8 + 2] * scale, x[i * 8 + 3] * scale);
        w.z = pk2(x[i * 8 + 4] * scale, x[i * 8 + 5] * scale); w.w = pk2(x[i * 8 + 6] * scale, x[i * 8 + 7] * scale); ((u32x4*)ptr)[i] = w; }
}
__device__ __forceinline__ void transpose64(const bf16_t* __restrict__ src, bf16_t* __restrict__ dst, LAS bf16_t* T) {
    const int tid = opq_tid(), r = tid >> 3, c8 = (tid & 7) * 8;
    const u32x4 v = *(const u32x4*)(src + r * 64 + c8);
    __syncthreads();
    T[(c8 + 0) * 72 + r] = (bf16_t)(v.x & 0xffff); T[(c8 + 1) * 72 + r] = (bf16_t)(v.x >> 16); T[(c8 + 2) * 72 + r] = (bf16_t)(v.y & 0xffff); T[(c8 + 3) * 72 + r] = (bf16_t)(v.y >> 16);
    T[(c8 + 4) * 72 + r] = (bf16_t)(v.z & 0xffff); T[(c8 + 5) * 72 + r] = (bf16_t)(v.z >> 16); T[(c8 + 6) * 72 + r] = (bf16_t)(v.w & 0xffff); T[(c8 + 7) * 72 + r] = (bf16_t)(v.w >> 16);
    __syncthreads();
    *(u32x4*)(dst + r * 64 + c8) = *(const LAS u32x4*)(T + r * 72 + c8);
}
__device__ void postproc_item(const Params& p, int l, int item, LAS unsigned char* lds) {
    asm volatile("" : "+s"(l), "+s"(item));
    unsigned char* ws = p.ws; int tid = opq_tid(); asm volatile("" : "+v"(tid));
    const int b = item >> 6, blk = item & 63, tok0 = b * SEQ + blk * 64;
    const float* rope = (const float*)(ws + WS_ROPE);
    {
        const int tk = tid >> 3, h = tid & 7, tok = tok0 + tk;
        norm_vec64<false, true>((bf16_t*)(ws + WS_QN) + (size_t)tok * 512 + h * 64, p.in[I_NQ_NORM] + l * 64, rope + (size_t)tok * 16, 0.125f);
    }
    {
        const int tk = tid >> 3, hh = tid & 7, tok = tok0 + tk;
        norm_vec64<true, false>((bf16_t*)(ws + WS_MQ) + (size_t)tok * 512 + hh * 64, p.in[I_MEM_QN] + l * 128 + (hh & 1) * 64, nullptr, 0.08838834764831845f);
    }
    if (tid < 256) {
        const int tk = tid >> 2, g = (tid >> 1) & 1, which = tid & 1, tok = tok0 + tk;
        bf16_t* base = (bf16_t*)(ws + (which ? WS_KW : WS_KS)) + ((size_t)(b * 2 + g) * SEQ + blk * 64 + tk) * 64;
        norm_vec64<false, true>(base, p.in[I_NK_NORM] + (l * 3 + 1 + which) * 64, rope + (size_t)tok * 16, 1.0f);
    }
    LAS bf16_t* T = (LAS bf16_t*)lds;
#pragma unroll 1
    for (int j = 0; j < 4; ++j) { const int g = j & 1, which = j >> 1; const size_t off = ((size_t)(b * 2 + g) * SEQ + blk * 64) * 64;
        transpose64((const bf16_t*)(ws + (which ? WS_VW : WS_VS)) + off, (bf16_t*)(ws + (which ? WS_VTW : WS_VTS)) + off, T); }
    __syncthreads();
}
__device__ void phase_c2(const Params& p, int l) {
    asm volatile("" : "+s"(l));
    unsigned char* ws = p.ws; const int lane = opq_tid() & 63; const int gw = opq_bid() * 8 + (opq_tid() >> 6), nw = opq_gdim() * 8;
    const bf16_t* HID = (const bf16_t*)(ws + WS_HID);
    bf16_t* KCMP = (bf16_t*)(ws + WS_KCMP); bf16_t* VCMPT = (bf16_t*)(ws + WS_VCMPT);
    const float* rope = (const float*)(ws + WS_ROPE);
    for (int it = gw; it < 2048; it += nw) {
        const int kv = it >> 10, bg = (it >> 6) & 15, n0 = (it & 63) * 4;
        const float* W2 = p.in[I_CMP_W2] + ((size_t)l * 2 + kv) * 256 * 64;
        const bf16_t* hr = HID + ((size_t)kv * 4096 + bg * 256 + n0) * 256;
        float a0 = 0.f, a1 = 0.f, a2 = 0.f, a3 = 0.f;
        for (int e = 0; e < 256; ++e) { const float w = W2[e * 64 + lane]; a0 += bf2f(hr[e]) * w; a1 += bf2f(hr[256 + e]) * w; a2 += bf2f(hr[512 + e]) * w; a3 += bf2f(hr[768 + e]) * w; }
        float av[4] = {a0, a1, a2, a3};
#pragma unroll
        for (int r = 0; r < 4; ++r) {
            const int n = n0 + r; float v = av[r];
            if (kv == 0) {
                if (n < 255) {
                    const float ss = wave_sum(v * v); v = v / sqrtf(ss * (1.0f / 64.0f) + 1e-6f) * p.in[I_NK_NORM][(l * 3 + 0) * 64 + lane];
                    const int tok = (bg >> 1) * SEQ + 16 * n + 31; const float* rt = rope + (size_t)tok * 16;
                    const float oth = __shfl_xor(v, 8);
                    if (lane < 8) v = v * rt[lane] - oth * rt[8 + lane]; else if (lane < 16) v = v * rt[lane - 8] + oth * rt[lane];
                } else v = 0.f;
                KCMP[((size_t)bg * 256 + n) * 64 + lane] = f2bf(v);
            } else {
                if (n >= 255) v = 0.f;
                VCMPT[((size_t)bg * 64 + lane) * 256 + n] = f2bf(v);
            }
        }
    }
    const bf16_t* MKV = (const bf16_t*)(ws + WS_MKV); bf16_t* MK = (bf16_t*)(ws + WS_MK); bf16_t* MVT = (bf16_t*)(ws + WS_MVT);
    for (int it = gw; it < 8192; it += nw) {
        const int row = it >> 2, h = it & 3, b = row >> 8, m = row & 255;
        const unsigned kk = *(const unsigned*)(MKV + (size_t)row * 1024 + h * 128 + lane * 2);
        float k0 = __uint_as_float(kk << 16), k1 = __uint_as_float(kk & 0xffff0000u);
        const float ss = wave_sum(k0 * k0 + k1 * k1); const float rstd = 1.0f / sqrtf(ss * (1.0f / 128.0f) + 1e-6f);
        const float* gn = p.in[I_MEM_KN] + l * 128 + lane * 2;
        *(unsigned*)(MK + ((size_t)(b * 4 + h) * 256 + m) * 128 + lane * 2) = pk2(k0 * rstd * gn[0], k1 * rstd * gn[1]);
        const unsigned vv = *(const unsigned*)(MKV + (size_t)row * 1024 + 512 + h * 128 + lane * 2);
        bf16_t* vt = MVT + ((size_t)(b * 4 + h) * 128 + lane * 2) * 256 + m;
        vt[0] = (bf16_t)(vv & 0xffff); vt[256] = (bf16_t)(vv >> 16);
    }
}
#define MFMA16(a, b, c) __builtin_amdgcn_mfma_f32_16x16x32_bf16((a), (b), (c), 0, 0, 0)
template <int DH> struct KVRegs { u32x4 k[DH / 64], v[DH / 64]; };
template <int DH>
__device__ __forceinline__ void kv_load(KVRegs<DH>& r, const bf16_t* __restrict__ gK, int ldk, const bf16_t* __restrict__ gVt, int ldv) {
    const int tid = opq_tid();
#pragma unroll
    for (int i = 0; i < DH / 64; ++i) {
        const int idx = tid + i * 512; const int kr = idx / (DH / 8), kc = (idx % (DH / 8)) * 8;
        r.k[i] = *(const u32x4*)(gK + (size_t)kr * ldk + kc);
        const int vr = idx >> 3, vc = (idx & 7) * 8;
        r.v[i] = *(const u32x4*)(gVt + (size_t)vr * ldv + vc);
    }
}
template <int DH>
__device__ __forceinline__ void kv_store(const KVRegs<DH>& r, LAS bf16_t* Kt, LAS bf16_t* Vt) {
    const int tid = opq_tid();
#pragma unroll
    for (int i = 0; i < DH / 64; ++i) {
        const int idx = tid + i * 512; const int kr = idx / (DH / 8), kc = (idx % (DH / 8)) * 8;
        *(LAS u32x4*)(Kt + kr * (DH + 8) + kc) = r.k[i];
        const int vr = idx >> 3, vc = (idx & 7) * 8;
        *(LAS u32x4*)(Vt + vr * 72 + vc) = r.v[i];
    }
}
template <int DH>
__device__ __forceinline__ void qk_scores(const LAS bf16_t* Kt, const bf16x8 (&qf)[2][DH / 32], f32x4 (&st)[4][2], int fr, int fq) {
#pragma unroll
    for (int kt = 0; kt < 4; ++kt) {
        st[kt][0] = (f32x4){0.f, 0.f, 0.f, 0.f}; st[kt][1] = (f32x4){0.f, 0.f, 0.f, 0.f};
#pragma unroll
        for (int ks = 0; ks < DH / 32; ++ks) {
            const bf16x8 a = *(const LAS bf16x8*)(Kt + (kt * 16 + fr) * (DH + 8) + ks * 32 + fq * 8);
            st[kt][0] = MFMA16(a, qf[0][ks], st[kt][0]); st[kt][1] = MFMA16(a, qf[1][ks], st[kt][1]);
        }
    }
}
template <int DH> struct FlashState { float m[2], l[2]; f32x4 O[DH / 16][2]; };
template <int DH> __device__ __forceinline__ void flash_init(FlashState<DH>& s) {
    s.m[0] = s.m[1] = -1e30f; s.l[0] = s.l[1] = 0.f;
#pragma unroll
    for (int d = 0; d < DH / 16; ++d) { s.O[d][0] = (f32x4){0.f, 0.f, 0.f, 0.f}; s.O[d][1] = (f32x4){0.f, 0.f, 0.f, 0.f}; }
}
template <int DH>
__device__ __forceinline__ void flash_step(const LAS bf16_t* Kt, const LAS bf16_t* Vt, const bf16x8 (&qf)[2][DH / 32], const u64 (&mask)[2], FlashState<DH>& s, int fr, int fq) {
    f32x4 st[4][2];
    qk_scores<DH>(Kt, qf, st, fr, fq);
    bf16x8 pb[2][2];
#pragma unroll
    for (int qt = 0; qt < 2; ++qt) {
        const u64 msh = mask[qt] >> (fq * 4);
        float mx = s.m[qt];
#pragma unroll
        for (int kt = 0; kt < 4; ++kt)
#pragma unroll
            for (int j = 0; j < 4; ++j) { const bool ok = (msh >> (kt * 16 + j)) & 1ull; const float v = ok ? st[kt][qt][j] : -1e30f; st[kt][qt][j] = v; mx = fmaxf(mx, v); }
        mx = fmaxf(mx, __shfl_xor(mx, 16)); mx = fmaxf(mx, __shfl_xor(mx, 32));
        const float alpha = __expf(s.m[qt] - mx); s.m[qt] = mx;
        float ps = 0.f;
#pragma unroll
        for (int kt = 0; kt < 4; ++kt)
#pragma unroll
            for (int j = 0; j < 4; ++j) { const float v = st[kt][qt][j]; const float pv = v > -1e29f ? __expf(v - mx) : 0.f; st[kt][qt][j] = pv; ps += pv; }
        s.l[qt] = s.l[qt] * alpha + ps;
#pragma unroll
        for (int d = 0; d < DH / 16; ++d) s.O[d][qt] *= alpha;
#pragma unroll
        for (int kb = 0; kb < 2; ++kb) {
            bf16x8 t;
#pragma unroll
            for (int j = 0; j < 4; ++j) { t[j] = (short)f2bf(st[2 * kb][qt][j]); t[4 + j] = (short)f2bf(st[2 * kb + 1][qt][j]); }
            pb[kb][qt] = t;
        }
    }
#pragma unroll
    for (int d = 0; d < DH / 16; ++d)
#pragma unroll
        for (int kb = 0; kb < 2; ++kb) {
            const bf16x4 lo = *(const LAS bf16x4*)(Vt + (d * 16 + fr) * 72 + kb * 32 + fq * 4);
            const bf16x4 hi = *(const LAS bf16x4*)(Vt + (d * 16 + fr) * 72 + kb * 32 + 16 + fq * 4);
            const bf16x8 a = __builtin_shufflevector(lo, hi, 0, 1, 2, 3, 4, 5, 6, 7);
            s.O[d][0] = MFMA16(a, pb[kb][0], s.O[d][0]); s.O[d][1] = MFMA16(a, pb[kb][1], s.O[d][1]);
        }
}
__device__ __forceinline__ u64 low_mask(int n) { return n >= 63 ? ~0ull : (n < 0 ? 0ull : ((2ull << n) - 1ull)); }

template <int MODE  >
__device__ __forceinline__ void nsa_run(LAS unsigned char* lds, u64 blocks, const bf16_t* Kb, size_t kstr, int ldk, const bf16_t* Vb, size_t vstr, int ldv,
                                        const bf16x8 (&qf)[2][2], FlashState<64>& fs, int qi, const int (&tq)[2], const int (&qidx)[2], int fr, int fq) {
    LAS bf16_t* Kt[2] = {(LAS bf16_t*)lds, (LAS bf16_t*)(lds + 9216)}; LAS bf16_t* Vt[2] = {(LAS bf16_t*)(lds + 18432), (LAS bf16_t*)(lds + 27648)};
    const LAS u64* sel = (const LAS u64*)(lds + 103424);
    if (blocks == 0ull) return;
    KVRegs<64> r; int j = __builtin_ctzll(blocks); blocks &= blocks - 1;
    kv_load<64>(r, Kb + (size_t)j * kstr, ldk, Vb + (size_t)j * vstr, ldv);
    int par = 0;
    __syncthreads();
    for (;;) {
        kv_store<64>(r, Kt[par], Vt[par]);
        __syncthreads();
        const int jc = j; const bool more = blocks != 0ull;
        if (more) { j = __builtin_ctzll(blocks); blocks &= blocks - 1; kv_load<64>(r, Kb + (size_t)j * kstr, ldk, Vb + (size_t)j * vstr, ldv); }
        u64 mask[2];
#pragma unroll
        for (int qt = 0; qt < 2; ++qt) {
            if (MODE == 0) { const int t = qi * 64 + tq[qt]; const int nlim = t >= 31 ? ((t - 31) >> 4) : -1; mask[qt] = low_mask(nlim - 64 * jc); }
            else if (MODE == 1) { const u64 sm = sel[qidx[qt]]; mask[qt] = ((sm >> jc) & 1ull) ? (jc == qi ? low_mask(tq[qt]) : ~0ull) : 0ull; }
            else { mask[qt] = jc == qi ? low_mask(tq[qt]) : (jc == qi - 8 ? ~low_mask(tq[qt]) : ~0ull); }
        }
        flash_step<64>(Kt[par], Vt[par], qf, mask, fs, fr, fq);
        par ^= 1;
        if (!more) break;
    }
}
__device__ void nsa_item(const Params& p, int l, int item, LAS unsigned char* lds) {
    asm volatile("" : "+s"(l), "+s"(item));
    unsigned char* ws = p.ws;
    const int qi = 63 - (item >> 4), bg = item & 15, b = bg >> 1, g = bg & 1;
    int tid = opq_tid(); asm volatile("" : "+v"(tid));
    const int w = tid >> 6, lane = tid & 63, fr = lane & 15, fq = lane >> 4;
    const int r = w >> 1, h = g * 4 + r;
    int tq[2], qidx[2]; tq[0] = (w & 1) * 32 + fr; tq[1] = tq[0] + 16; qidx[0] = tq[0]; qidx[1] = tq[1];
    const int tok0 = b * SEQ + qi * 64;
    bf16_t* QN = (bf16_t*)(ws + WS_QN);
    bf16x8 qf[2][2];
#pragma unroll
    for (int qt = 0; qt < 2; ++qt)
#pragma unroll
        for (int ks = 0; ks < 2; ++ks) qf[qt][ks] = *(const bf16x8*)(QN + (size_t)(tok0 + tq[qt]) * 512 + h * 64 + ks * 32 + fq * 8);
    float gate[2][3];
#pragma unroll
    for (int qt = 0; qt < 2; ++qt)
#pragma unroll
        for (int k = 0; k < 3; ++k) gate[qt][k] = sigmoidf_(((const float*)(ws + WS_SM))[(size_t)(tok0 + tq[qt]) * 40 + h * 3 + k]);
    LAS float* imp = (LAS float*)(lds + 36864); LAS u64* sel = (LAS u64*)(lds + 103424);
    f32x4 fin[4][2];
#pragma unroll
    for (int d = 0; d < 4; ++d) { fin[d][0] = (f32x4){0.f, 0.f, 0.f, 0.f}; fin[d][1] = (f32x4){0.f, 0.f, 0.f, 0.f}; }
    FlashState<64> fs;
#define NSA_ACCUM(k) do { _Pragma("unroll") for (int qt = 0; qt < 2; ++qt) { float lt = fs.l[qt]; lt += __shfl_xor(lt, 16); lt += __shfl_xor(lt, 32); fs.l[qt] = lt; \
        const float sc = lt > 0.f ? gate[qt][k] / lt : 0.f; _Pragma("unroll") for (int d = 0; d < 4; ++d) fin[d][qt] += fs.O[d][qt] * sc; } } while (0)
    const int ncb = ((4 * qi + 2) >> 6) + 1;
    const bf16_t* KC = (const bf16_t*)(ws + WS_KCMP) + (size_t)bg * 256 * 64; const bf16_t* VC = (const bf16_t*)(ws + WS_VCMPT) + (size_t)bg * 64 * 256;
    flash_init<64>(fs);
    nsa_run<0>(lds, (1ull << ncb) - 1ull, KC, 4096, 64, VC, 64, 256, qf, fs, qi, tq, qidx, fr, fq);
    NSA_ACCUM(0);
    if (qi >= 15) {
        LAS bf16_t* Kt0 = (LAS bf16_t*)lds;
        float inv[2]; inv[0] = fs.l[0] > 0.f ? 1.0f / fs.l[0] : 0.f; inv[1] = fs.l[1] > 0.f ? 1.0f / fs.l[1] : 0.f;
        float carry[2] = {0.f, 0.f};
        for (int cb = 0; cb < ncb; ++cb) {
            { const int kr = tid >> 3, kc = (tid & 7) * 8; const u32x4 v = *(const u32x4*)(KC + (size_t)cb * 4096 + kr * 64 + kc); __syncthreads(); *(LAS u32x4*)(Kt0 + kr * 72 + kc) = v; __syncthreads(); }
            f32x4 st[4][2]; qk_scores<64>(Kt0, qf, st, fr, fq);
#pragma unroll
            for (int qt = 0; qt < 2; ++qt) {
                const int t = qi * 64 + tq[qt]; const int nlim = (t - 31) >> 4;
#pragma unroll
                for (int kt = 0; kt < 4; ++kt) {
                    const int n0 = cb * 64 + kt * 16 + fq * 4; float pj[4];
#pragma unroll
                    for (int j = 0; j < 4; ++j) pj[j] = (n0 + j <= nlim) ? __expf(st[kt][qt][j] - fs.m[qt]) * inv[qt] : 0.f;
                    const float gs = (pj[0] + pj[1]) + (pj[2] + pj[3]);
                    const float up = __shfl(pj[3], (lane + 48) & 63);
                    const float prev = fq > 0 ? up : carry[qt];
                    if (fq == 0) carry[qt] = up;
                    imp[(r * 64 + qidx[qt]) * 65 + (n0 >> 2)] = gs + prev;
                }
            }
        }
        __syncthreads();
        {
            const int q = tid >> 3, sub = tid & 7; unsigned byte = 0u;
            for (int jj = 0; jj < 8; ++jj) {
                const int j = sub * 8 + jj; if (j > qi) break;
                const float sj = (j == 0 || j >= qi - 1) ? 1e4f : ((imp[q * 65 + j] + imp[(64 + q) * 65 + j]) + (imp[(128 + q) * 65 + j] + imp[(192 + q) * 65 + j])); int rank = 0;
                for (int k = 0; k <= qi; ++k) { const float sk = (k == 0 || k >= qi - 1) ? 1e4f : ((imp[q * 65 + k] + imp[(64 + q) * 65 + k]) + (imp[(128 + q) * 65 + k] + imp[(192 + q) * 65 + k])); rank += (sk > sj || (sk == sj && k < j)) ? 1 : 0; }
                if (rank < 16) byte |= 1u << jj;
            }
            ((LAS unsigned char*)sel)[q * 8 + sub] = (unsigned char)byte;
        }
    } else {
        if (tid < 64) sel[tid] = low_mask(qi);
    }
    __syncthreads();
    u64 uni;
    { u64 v = sel[lane]; unsigned lo = (unsigned)v, hi = (unsigned)(v >> 32);
#pragma unroll
      for (int o = 32; o >= 1; o >>= 1) { lo |= __shfl_xor(lo, o); hi |= __shfl_xor(hi, o); }
      uni = ((u64)(unsigned)__builtin_amdgcn_readfirstlane(hi) << 32) | (unsigned)__builtin_amdgcn_readfirstlane(lo); }
    flash_init<64>(fs);
    nsa_run<1>(lds, uni & low_mask(qi), (const bf16_t*)(ws + WS_KS) + (size_t)bg * SEQ * 64, 4096, 64, (const bf16_t*)(ws + WS_VTS) + (size_t)bg * SEQ * 64, 4096, 64, qf, fs, qi, tq, qidx, fr, fq);
    NSA_ACCUM(1);
    flash_init<64>(fs);
    { const int j0 = qi >= 8 ? qi - 8 : 0; const u64 wb = low_mask(qi) & ~(j0 > 0 ? low_mask(j0 - 1) : 0ull);
      nsa_run<2>(lds, wb, (const bf16_t*)(ws + WS_KW) + (size_t)bg * SEQ * 64, 4096, 64, (const bf16_t*)(ws + WS_VTW) + (size_t)bg * SEQ * 64, 4096, 64, qf, fs, qi, tq, qidx, fr, fq); }
    NSA_ACCUM(2);
#undef NSA_ACCUM
#pragma unroll
    for (int qt = 0; qt < 2; ++qt)
#pragma unroll
        for (int d = 0; d < 4; ++d) { u32x2 o; o.x = pk2(fin[d][qt][0], fin[d][qt][1]); o.y = pk2(fin[d][qt][2], fin[d][qt][3]);
            *(u32x2*)(QN + (size_t)(tok0 + tq[qt]) * 512 + h * 64 + d * 16 + fq * 4) = o; }
    __syncthreads();
}
__device__ void mem_item(const Params& p, int item, LAS unsigned char* lds) {
    asm volatile("" : "+s"(item));
    unsigned char* ws = p.ws;
    const int qb = item & 15, bh = item >> 4, b = bh >> 2, h = bh & 3;
    int tid = opq_tid(); asm volatile("" : "+v"(tid));
    const int w = tid >> 6, lane = tid & 63, fr = lane & 15, fq = lane >> 4;
    bf16_t* MQ = (bf16_t*)(ws + WS_MQ);
    const int tokb = b * SEQ + qb * 256 + w * 32;
    bf16x8 qf[2][4];
#pragma unroll
    for (int qt = 0; qt < 2; ++qt)
#pragma unroll
        for (int ks = 0; ks < 4; ++ks) qf[qt][ks] = *(const bf16x8*)(MQ + (size_t)(tokb + qt * 16 + fr) * 512 + h * 128 + ks * 32 + fq * 8);
    const bf16_t* Kb = (const bf16_t*)(ws + WS_MK) + (size_t)bh * 256 * 128; const bf16_t* Vb = (const bf16_t*)(ws + WS_MVT) + (size_t)bh * 128 * 256;
    LAS bf16_t* Kt[2] = {(LAS bf16_t*)lds, (LAS bf16_t*)(lds + 17408)}; LAS bf16_t* Vt[2] = {(LAS bf16_t*)(lds + 34816), (LAS bf16_t*)(lds + 53248)};
    FlashState<128> fs; flash_init<128>(fs);
    KVRegs<128> r; kv_load<128>(r, Kb, 128, Vb, 256);
    u64 mask[2] = {~0ull, ~0ull};
    __syncthreads();
#pragma unroll 1
    for (int j = 0; j < 4; ++j) {
        kv_store<128>(r, Kt[j & 1], Vt[j & 1]);
        __syncthreads();
        if (j < 3) kv_load<128>(r, Kb + (size_t)(j + 1) * 64 * 128, 128, Vb + (j + 1) * 64, 256);
        flash_step<128>(Kt[j & 1], Vt[j & 1], qf, mask, fs, fr, fq);
    }
#pragma unroll
    for (int qt = 0; qt < 2; ++qt) {
        float lt = fs.l[qt]; lt += __shfl_xor(lt, 16); lt += __shfl_xor(lt, 32); const float sc = 1.0f / lt;
#pragma unroll
        for (int d = 0; d < 8; ++d) { const f32x4 o = fs.O[d][qt] * sc; u32x2 v; v.x = pk2(o[0], o[1]); v.y = pk2(o[2], o[3]);
            *(u32x2*)(MQ + (size_t)(tokb + qt * 16 + fr) * 512 + h * 128 + d * 16 + fq * 4) = v; }
    }
    __syncthreads();
}
__device__ void gla_item(const Params& p, int l, int item, LAS unsigned char* lds) {
    asm volatile("" : "+s"(l), "+s"(item));
    unsigned char* ws = p.ws;
    const int b = item >> 2, h = item & 3;
    int tid = opq_tid(); asm volatile("" : "+v"(tid));
    const int w = __builtin_amdgcn_readfirstlane(tid >> 6), lane = tid & 63, fr = lane & 15, fq = lane >> 4;
    LAS bf16_t* Qt = (LAS bf16_t*)lds; LAS bf16_t* Kt = (LAS bf16_t*)(lds + 9216); LAS bf16_t* Kht = (LAS bf16_t*)(lds + 18432); LAS bf16_t* At = (LAS bf16_t*)(lds + 27648);
    LAS bf16_t* Vt = (LAS bf16_t*)(lds + 36864); LAS bf16_t* St = (LAS bf16_t*)(lds + 55296); LAS float* segsum = (LAS float*)(lds + 73728); LAS float* eb = (LAS float*)(lds + 75776);
    const int d = lane, seg = w;
    float wg[16];
#pragma unroll
    for (int r = 0; r < 16; ++r) wg[r] = p.in[I_GLA_WG][((size_t)l * 16 + r) * 256 + h * 64 + d];
    const float bgv = p.in[I_GLA_BG][l * 256 + h * 64 + d];
    const float* SM = (const float*)(ws + WS_SM);
    const bf16_t* GQ = (const bf16_t*)(ws + WS_GQ) + (size_t)(b * 4 + h) * SEQ * 64; const bf16_t* GK = (const bf16_t*)(ws + WS_GK) + (size_t)(b * 4 + h) * SEQ * 64;
    const bf16_t* GV = (const bf16_t*)(ws + WS_GV) + (size_t)(b * 4 + h) * SEQ * 128; bf16_t* GR = (bf16_t*)(ws + WS_GR);
    f32x4 Sreg[2][4];
#pragma unroll
    for (int a = 0; a < 2; ++a)
#pragma unroll
        for (int c = 0; c < 4; ++c) Sreg[a][c] = (f32x4){0.f, 0.f, 0.f, 0.f};
    float gn[8];
#pragma unroll
    for (int vt = 0; vt < 8; ++vt) gn[vt] = p.in[I_GLA_NORM][l * 128 + vt * 16 + fr];
    __syncthreads();
#pragma unroll 1
    for (int c = 0; c < 64; ++c) {
        const int t0 = c * 64;
        float cs[8]; float run = 0.f;
#pragma unroll
        for (int ii = 0; ii < 8; ++ii) {
            const float* gl = SM + (size_t)(b * SEQ + t0 + seg * 8 + ii) * 40 + 24;
            float x = bgv;
#pragma unroll
            for (int r4 = 0; r4 < 4; ++r4) { const f32x4 gvv = *(const f32x4*)(gl + r4 * 4); x += gvv[0] * wg[r4 * 4] + gvv[1] * wg[r4 * 4 + 1] + gvv[2] * wg[r4 * 4 + 2] + gvv[3] * wg[r4 * 4 + 3]; }
            const float ls = fminf(x, 0.f) - __logf(1.0f + __expf(-fabsf(x)));
            run += ls * (1.0f / 16.0f); cs[ii] = run;
        }
        segsum[seg * 64 + d] = run;
        float qv[8], kv[8];
#pragma unroll
        for (int ii = 0; ii < 8; ++ii) { const size_t o = (size_t)(t0 + seg * 8 + ii) * 64 + d; qv[ii] = bf2f(GQ[o]); kv[ii] = bf2f(GK[o]); }
        u32x4 vraw[2];
#pragma unroll
        for (int pc = 0; pc < 2; ++pc) { const int idx = tid + pc * 512; vraw[pc] = *(const u32x4*)(GV + (size_t)(t0 + (idx >> 4)) * 128 + (idx & 15) * 8); }
        __syncthreads();
        float pre = 0.f, tot = 0.f;
#pragma unroll
        for (int s2 = 0; s2 < 8; ++s2) { const float v = segsum[s2 * 64 + d]; tot += v; if (s2 < seg) pre += v; }
#pragma unroll
        for (int ii = 0; ii < 8; ++ii) {
            const int i = seg * 8 + ii; const float bi = pre + cs[ii];
            Qt[i * 72 + d] = f2bf(qv[ii] * __expf(bi) * 0.125f);
            Kt[i * 72 + d] = f2bf(kv[ii] * __expf(-bi));
            Kht[d * 72 + i] = f2bf(kv[ii] * __expf(tot - bi));
        }
        if (seg == 0) eb[d] = __expf(tot);
#pragma unroll
        for (int pc = 0; pc < 2; ++pc) { const int idx = tid + pc * 512; const int i = idx >> 4, v0 = (idx & 15) * 8; const u32x4 v = vraw[pc];
            Vt[(v0 + 0) * 72 + i] = (bf16_t)(v.x & 0xffff); Vt[(v0 + 1) * 72 + i] = (bf16_t)(v.x >> 16); Vt[(v0 + 2) * 72 + i] = (bf16_t)(v.y & 0xffff); Vt[(v0 + 3) * 72 + i] = (bf16_t)(v.y >> 16);
            Vt[(v0 + 4) * 72 + i] = (bf16_t)(v.z & 0xffff); Vt[(v0 + 5) * 72 + i] = (bf16_t)(v.z >> 16); Vt[(v0 + 6) * 72 + i] = (bf16_t)(v.w & 0xffff); Vt[(v0 + 7) * 72 + i] = (bf16_t)(v.w >> 16); }
        if (w >= 4) {
            const int ws4 = w - 4;
#pragma unroll
            for (int vl = 0; vl < 2; ++vl)
#pragma unroll
                for (int dt = 0; dt < 4; ++dt) { u32x2 o; o.x = pk2(Sreg[vl][dt][0], Sreg[vl][dt][1]); o.y = pk2(Sreg[vl][dt][2], Sreg[vl][dt][3]);
                    *(LAS u32x2*)(St + ((ws4 * 2 + vl) * 16 + fr) * 72 + dt * 16 + fq * 4) = o; }
        }
        __syncthreads();
        if (w < 4) {
            const int it = w;
#pragma unroll
            for (int jt = 0; jt < 4; ++jt) {
                f32x4 a4 = (f32x4){0.f, 0.f, 0.f, 0.f};
                if (jt <= it) {
#pragma unroll
                    for (int ks = 0; ks < 2; ++ks) { const bf16x8 a = *(const LAS bf16x8*)(Qt + (it * 16 + fr) * 72 + ks * 32 + fq * 8); const bf16x8 bb = *(const LAS bf16x8*)(Kt + (jt * 16 + fr) * 72 + ks * 32 + fq * 8); a4 = MFMA16(a, bb, a4); }
                    if (jt == it) {
#pragma unroll
                        for (int r = 0; r < 4; ++r) if (fr > fq * 4 + r) a4[r] = 0.f;
                    }
                }
#pragma unroll
                for (int r = 0; r < 4; ++r) At[(it * 16 + fq * 4 + r) * 72 + jt * 16 + fr] = f2bf(a4[r]);
            }
            f32x4 o[8];
#pragma unroll
            for (int vt = 0; vt < 8; ++vt) {
                f32x4 acc = (f32x4){0.f, 0.f, 0.f, 0.f};
#pragma unroll
                for (int ks = 0; ks < 2; ++ks) { const bf16x8 a = *(const LAS bf16x8*)(At + (it * 16 + fr) * 72 + ks * 32 + fq * 8); const bf16x8 bb = *(const LAS bf16x8*)(Vt + (vt * 16 + fr) * 72 + ks * 32 + fq * 8); acc = MFMA16(a, bb, acc); }
#pragma unroll
                for (int ks = 0; ks < 2; ++ks) { const bf16x8 a = *(const LAS bf16x8*)(Qt + (it * 16 + fr) * 72 + ks * 32 + fq * 8); const bf16x8 bb = *(const LAS bf16x8*)(St + (vt * 16 + fr) * 72 + ks * 32 + fq * 8); acc = MFMA16(a, bb, acc); }
                o[vt] = acc;
            }
#pragma unroll
            for (int r = 0; r < 4; ++r) {
                float ss = 0.f;
#pragma unroll
                for (int vt = 0; vt < 8; ++vt) ss += o[vt][r] * o[vt][r];
                ss += __shfl_xor(ss, 1); ss += __shfl_xor(ss, 2); ss += __shfl_xor(ss, 4); ss += __shfl_xor(ss, 8);
                const float rstd = 1.0f / sqrtf(ss * (1.0f / 128.0f) + 1e-6f);
                bf16_t* gp = GR + (size_t)(b * SEQ + t0 + it * 16 + fq * 4 + r) * 512 + h * 128 + fr;
#pragma unroll
                for (int vt = 0; vt < 8; ++vt) { const float rg = bf2f(gp[vt * 16]); gp[vt * 16] = f2bf(o[vt][r] * rstd * gn[vt] * rg * sigmoidf_(rg)); }
            }
        } else {
            const int ws4 = w - 4;
#pragma unroll
            for (int vl = 0; vl < 2; ++vl)
#pragma unroll
                for (int dt = 0; dt < 4; ++dt) {
                    f32x4 acc = Sreg[vl][dt];
#pragma unroll
                    for (int r = 0; r < 4; ++r) acc[r] *= eb[dt * 16 + fq * 4 + r];
#pragma unroll
                    for (int ks = 0; ks < 2; ++ks) { const bf16x8 a = *(const LAS bf16x8*)(Kht + (dt * 16 + fr) * 72 + ks * 32 + fq * 8); const bf16x8 bb = *(const LAS bf16x8*)(Vt + ((ws4 * 2 + vl) * 16 + fr) * 72 + ks * 32 + fq * 8); acc = MFMA16(a, bb, acc); }
                    Sreg[vl][dt] = acc;
                }
        }
        __syncthreads();
    }
}
__device__ __forceinline__ int fetch_item(unsigned* ctr, LAS int* slot) {
    __syncthreads(); if (opq_tid() == 0) *slot = (int)atomicAdd(ctr, 1u); __syncthreads(); return __builtin_amdgcn_readfirstlane(*slot);
}
#define AS4 __attribute__((address_space(4)))
#if defined(__HIP_DEVICE_COMPILE__)
#define PLOAD_ const Params p = *kp_;
#else
#define PLOAD_ const Params p = p_arg;
#endif
#define PH_BEGIN \
    const AS4 Params* kp_ = (const AS4 Params*)__builtin_amdgcn_kernarg_segment_ptr(); asm volatile("" : "+s"(kp_)); \
    PLOAD_ unsigned char* ws = p.ws; unsigned* ctl = (unsigned*)(ws + WS_CTL); (void)ctl; \
    int l = l_; asm volatile("" : "+s"(l)); \
    const int G = opq_gdim(), c = opq_bid(); (void)G; (void)c; \
    bf16_t* H = (bf16_t*)(ws + WS_H); bf16_t* HM = (bf16_t*)(ws + WS_HM); bf16_t* Gb = (bf16_t*)(ws + WS_G); bf16_t* MG = (bf16_t*)(ws + WS_MERGED); bf16_t* U = (bf16_t*)(ws + WS_U); \
    const bf16_t* WIN = (const bf16_t*)(ws + WS_WIN); const float* xin = l == 0 ? p.in[I_X] : p.out; \
    (void)H; (void)HM; (void)Gb; (void)MG; (void)U; (void)WIN; (void)xin;
__global__ void __launch_bounds__(512, 2) fwd_kernel(Params p_arg) {
    extern __shared__ __attribute__((aligned(16))) unsigned char lds_raw[];
    LAS unsigned char* lds = (LAS unsigned char*)lds_raw;
    LAS int* slot = (LAS int*)(lds + LDS_BYTES - 16);
    cg::grid_group grid = cg::this_grid();
#pragma unroll 1
    for (int l_ = 0; l_ < DEPTH; ++l_) {
#if !defined(ONLY) || ONLY == 0
        { PH_BEGIN
        if (l == 0) phase_rope_table(p);
        phase_convert(p, l, lds);
        phase_bias1(p, l, lds);
        phase_rmsnorm(xin, p.in[I_LN_MIX] + l * 1024, H, NT);
        phase_rmsnorm(p.in[I_MEM], p.in[I_MEM_NORM] + l * 1024, HM, 2048); }
        grid.sync();
#endif
#if !defined(ONLY) || ONLY == 1
        { PH_BEGIN
        { StaticOrder S; S.init(NT, 3584, G, c); EpiInProj E{ws}; gemm_phase(lds, Gemm{H, WIN, NT, 3584, 1024, 1024, 1024}, S, E); }
        { StaticOrder S; S.init(16384, 3072, G, c); EpiGates E{Gb, p.in[I_B_MERGE] + l * 3072}; gemm_phase(lds, Gemm{H, WIN + (size_t)3584 * 1024, 16384, 3072, 1024, 1024, 1024}, S, E); } }
        grid.sync();
#endif
#if !defined(ONLY) || ONLY == 2
        { PH_BEGIN
        { StaticOrder S; S.init(4096, 256, G, c); EpiHid E{(bf16_t*)(ws + WS_HID), (const float*)(ws + WS_B1)}; gemm_phase(lds, Gemm{(const bf16_t*)(ws + WS_KC), (const bf16_t*)(ws + WS_W1), 4096, 256, 2048, 1024, 2048}, S, E); }
        { StaticOrder S; S.init(4096, 256, G, c - 16); EpiHid E{(bf16_t*)(ws + WS_HID) + (size_t)4096 * 256, (const float*)(ws + WS_B1) + 256}; gemm_phase(lds, Gemm{(const bf16_t*)(ws + WS_VC), (const bf16_t*)(ws + WS_W1) + (size_t)256 * 2048, 4096, 256, 2048, 1024, 2048}, S, E); }
        { StaticOrder S; S.init(2048, 1024, G, c - 32); EpiPlain E{(bf16_t*)(ws + WS_MKV), 1024}; gemm_phase(lds, Gemm{HM, (const bf16_t*)(ws + WS_WKV), 2048, 1024, 1024, 1024, 1024}, S, E); } }
        { PH_BEGIN
        for (;;) { const int it = fetch_item(ctl + l * 4 + 0, slot); if (it >= 512) break; postproc_item(p, l, it, lds); } }
        grid.sync();
#endif
#if !defined(ONLY) || ONLY == 3
        { PH_BEGIN
        phase_c2(p, l); }
        grid.sync();
#endif
#if !defined(ONLY) || ONLY == 4
        { PH_BEGIN
        for (;;) { const int it = fetch_item(ctl + l * 4 + 1, slot); if (it >= 32) break; gla_item(p, l, it, lds); } }
        { PH_BEGIN
        for (;;) { const int it = fetch_item(ctl + l * 4 + 2, slot); if (it >= 1024) break; nsa_item(p, l, it, lds); } }
        { PH_BEGIN
        for (;;) { const int it = fetch_item(ctl + l * 4 + 3, slot); if (it >= 512) break; mem_item(p, it, lds); } }
        grid.sync();
#endif
#if !defined(ONLY) || ONLY == 5
#pragma unroll 1
        for (int half = 0; half < 2; ++half) {
            if (half == 1) {
                { PH_BEGIN const size_t ro = 16384;
                { StaticOrder S; S.init(16384, 3072, G, c); EpiGates E{Gb, p.in[I_B_MERGE] + l * 3072}; gemm_phase(lds, Gemm{H + ro * 1024, WIN + (size_t)3584 * 1024, 16384, 3072, 1024, 1024, 1024}, S, E); } }
                grid.sync();
            }
            { PH_BEGIN int hf = half; asm volatile("" : "+s"(hf)); const size_t ro = (size_t)hf * 16384;
            { StaticOrder S; S.init(16384, 1024, G, c); EpiMerge<0> E{MG + ro * 1024, Gb, 0}; gemm_phase(lds, Gemm{(const bf16_t*)(ws + WS_QN) + ro * 512, (const bf16_t*)(ws + WS_WBR), 16384, 1024, 512, 512, 512}, S, E); }
            { StaticOrder S; S.init(16384, 1024, G, c); EpiMerge<1> E{MG + ro * 1024, Gb, 1}; gemm_phase(lds, Gemm{(const bf16_t*)(ws + WS_GR) + ro * 512, (const bf16_t*)(ws + WS_WBR) + (size_t)1024 * 512, 16384, 1024, 512, 512, 512}, S, E); }
            { StaticOrder S; S.init(16384, 1024, G, c); EpiMerge<1> E{MG + ro * 1024, Gb, 2}; gemm_phase(lds, Gemm{(const bf16_t*)(ws + WS_MQ) + ro * 512, (const bf16_t*)(ws + WS_WBR) + (size_t)2048 * 512, 16384, 1024, 512, 512, 512}, S, E); } }
            grid.sync();
        }
#endif
#if !defined(ONLY) || ONLY == 6
        { PH_BEGIN
        { StaticOrder S; S.init(NT, 1024, G, c); EpiResid E{xin, p.out}; gemm_phase(lds, Gemm{MG, (const bf16_t*)(ws + WS_WOUT), NT, 1024, 1024, 1024, 1024}, S, E); } }
        grid.sync();
#endif
#if !defined(ONLY) || ONLY == 7
        { PH_BEGIN
        phase_rmsnorm(p.out, p.in[I_LN_MLP] + l * 1024, H, NT); }
        grid.sync();
#endif
#if !defined(ONLY) || ONLY == 8
        { PH_BEGIN
        { StaticOrder S; S.init(NT, 4096, G, c); EpiRelu2 E{U}; gemm_phase(lds, Gemm{H, (const bf16_t*)(ws + WS_WUP), NT, 4096, 1024, 1024, 1024}, S, E); } }
        grid.sync();
#endif
#if !defined(ONLY) || ONLY == 9
        { PH_BEGIN
        { StaticOrder S; S.init(NT, 1024, G, c); EpiResid E{p.out, p.out}; gemm_phase(lds, Gemm{U, (const bf16_t*)(ws + WS_WDN), NT, 1024, 4096, 4096, 4096}, S, E); } }
        grid.sync();
#endif
    }
}

extern "C" void kernel_launch(void* const* d_in, const int* in_sizes, int n_in, void* d_out, int out_size, void* d_ws, size_t ws_size, hipStream_t stream) {
    static int grid = 0;
    if (grid == 0) {
        if (n_in != 23 || ws_size < WS_END) { fprintf(stderr, "kernel_launch: unexpected inputs (%d) or workspace (%zu < %zu)\n", n_in, ws_size, (size_t)WS_END); grid = -1; return; }
        int dev = 0, cus = 0, per_cu = 0;
        hipGetDevice(&dev); hipDeviceGetAttribute(&cus, hipDeviceAttributeMultiprocessorCount, dev);
        if (hipFuncSetAttribute((const void*)fwd_kernel, hipFuncAttributeMaxDynamicSharedMemorySize, LDS_BYTES) != hipSuccess) { fprintf(stderr, "kernel_launch: hipFuncSetAttribute failed\n"); grid = -1; return; }
        if (hipOccupancyMaxActiveBlocksPerMultiprocessor(&per_cu, (const void*)fwd_kernel, 512, LDS_BYTES) != hipSuccess || per_cu < 1) { fprintf(stderr, "kernel_launch: occupancy query says %d\n", per_cu); per_cu = 1; }
        (void)hipGetLastError();
        grid = cus * 1;
    }
    if (grid < 0) return;
    hipMemsetAsync((char*)d_ws + WS_CTL, 0, 4096, stream);
    Params p{};
    for (int i = 0; i < 23; ++i) p.in[i] = (const float*)d_in[i];
    p.out = (float*)d_out; p.ws = (unsigned char*)d_ws;
    for (int i = 0; i < 8; ++i) p.inv_freq[i] = powf(500000.0f, -(float)i / 8.0f);
    void* args[] = {&p};
    hipError_t e = hipLaunchCooperativeKernel((const void*)fwd_kernel, dim3(grid), dim3(512), args, LDS_BYTES, stream);
    if (e != hipSuccess) fprintf(stderr, "cooperative launch failed: %s (grid %d)\n", hipGetErrorString(e), grid);
}
```

```cpp
#include <hip/hip_runtime.h>
#include <hip/hip_cooperative_groups.h>
#include <cstdio>
#include <cmath>
namespace cg = cooperative_groups;
#define LAS __attribute__((address_space(3)))
typedef unsigned short bf16_t;
typedef short bf16x8 __attribute__((ext_vector_type(8)));
typedef short bf16x4 __attribute__((ext_vector_type(4)));
typedef float f32x4 __attribute__((ext_vector_type(4)));
typedef unsigned u32x4 __attribute__((ext_vector_type(4)));
typedef unsigned u32x2 __attribute__((ext_vector_type(2)));
typedef unsigned long long u64;

constexpr int NB = 8, SEQ = 4096, DM = 1024, NT = NB * SEQ, DEPTH = 4, DIN = 6440, NIN = 6656;
constexpr size_t MiB = 1048576;
constexpr size_t WS_CTL = 0;
constexpr size_t WS_ROPE = 4096;
constexpr size_t WS_WIN = WS_ROPE + 2 * MiB;
constexpr size_t WS_WBR = WS_WIN + 13 * MiB;
constexpr size_t WS_WOUT = WS_WBR + 3 * MiB;
constexpr size_t WS_WUP = WS_WOUT + 2 * MiB;
constexpr size_t WS_WDN = WS_WUP + 8 * MiB;
constexpr size_t WS_WKV = WS_WDN + 8 * MiB;
constexpr size_t WS_W1 = WS_WKV + 2 * MiB;
constexpr size_t WS_B1 = WS_W1 + 2 * MiB;
constexpr size_t WS_H = WS_B1 + 4096;
constexpr size_t WS_HM = WS_H + 64 * MiB;
constexpr size_t WS_QN = WS_HM + 4 * MiB;
constexpr size_t WS_KC = WS_QN + 32 * MiB;
constexpr size_t WS_VC = WS_KC + 8 * MiB;
constexpr size_t WS_KS = WS_VC + 8 * MiB;
constexpr size_t WS_KW = WS_KS + 8 * MiB;
constexpr size_t WS_VS = WS_KW + 8 * MiB;
constexpr size_t WS_VW = WS_VS + 8 * MiB;
constexpr size_t WS_VTS = WS_VW + 8 * MiB;
constexpr size_t WS_VTW = WS_VTS + 8 * MiB;
constexpr size_t WS_GQ = WS_VTW + 8 * MiB;
constexpr size_t WS_GK = WS_GQ + 16 * MiB;
constexpr size_t WS_GV = WS_GK + 16 * MiB;
constexpr size_t WS_GR = WS_GV + 32 * MiB;
constexpr size_t WS_MQ = WS_GR + 32 * MiB;
constexpr size_t WS_SM = WS_MQ + 32 * MiB;
constexpr size_t WS_G = WS_SM + 5 * MiB;
constexpr size_t WS_HID = WS_G + 96 * MiB;
constexpr size_t WS_KCMP = WS_HID + 4 * MiB;
constexpr size_t WS_VCMPT = WS_KCMP + MiB / 2;
constexpr size_t WS_MKV = WS_VCMPT + MiB / 2;
constexpr size_t WS_MK = WS_MKV + 4 * MiB;
constexpr size_t WS_MVT = WS_MK + 2 * MiB;
constexpr size_t WS_GS = WS_MVT + 2 * MiB;
constexpr size_t WS_EB = WS_GS + 32 * MiB;
constexpr size_t WS_WDN2 = WS_EB + MiB / 2;
constexpr size_t WS_END = WS_WDN2 + 9 * MiB;
constexpr int LDU = 4096 + 64;
constexpr size_t WS_MERGED = WS_KC;
constexpr size_t WS_U = WS_QN;
constexpr int LDS_BYTES = 147456;

__device__ __forceinline__ float bf2f(bf16_t b) { return __uint_as_float(((unsigned)b) << 16); }
__device__ __forceinline__ bf16_t f2bf(float f) { const __bf16 b = (__bf16)f; return __builtin_bit_cast(bf16_t, b); }
typedef float f32x2_t __attribute__((ext_vector_type(2)));
typedef __bf16 bf16x2_t __attribute__((ext_vector_type(2)));
__device__ __forceinline__ unsigned pk2(float lo, float hi) { const f32x2_t v = {lo, hi}; const bf16x2_t b = __builtin_convertvector(v, bf16x2_t); return __builtin_bit_cast(unsigned, b); }
__device__ __forceinline__ float sigmoidf_(float x) { return __builtin_amdgcn_rcpf(1.0f + __expf(-x)); }

__device__ __forceinline__ int opq_tid() { int t = threadIdx.x; asm volatile("" : "+v"(t)); return t; }
__device__ __forceinline__ int opq_bid() { int t = blockIdx.x; asm volatile("" : "+s"(t)); return t; }
__device__ __forceinline__ int opq_gdim() { int t = gridDim.x; asm volatile("" : "+s"(t)); return t; }
namespace pg8 {
constexpr int BM = 256, BK = 64, HALF = 128, HTB = HALF * BK * 2, STAGE_BYTES = 8 * HTB, NXCD = 8, WGM = 4;
__host__ __device__ __forceinline__ int lds_byte(int r, int c) { const int st = (r >> 4) * 2 + (c >> 5), rr = r & 15, cc = c & 31, ob = rr * 64 + cc * 2; return st * 1024 + (ob ^ (((ob >> 9) & 1) << 5)); }
__host__ __device__ __forceinline__ void stage_rc(int b, int& R, int& C) { const int st = b / 1024, sb = b % 1024, swz = sb ^ (((sb >> 9) & 1) << 5); R = (st >> 1) * 16 + swz / 64; C = (st & 1) * 32 + (swz % 64) / 2; }
__host__ __device__ __forceinline__ int perm32(int rho) { const int n = rho >> 4, i = rho & 15; return 8 * (i >> 2) + 4 * n + (i & 3); }
struct Unit { int pm, pn; };
struct Gemm { const bf16_t* A; const bf16_t* Bt; int M, N, K, lda, ldb; int blkA, blkB; };
struct StaticOrder {
    int nM, nN, nwg, G, c;
    __device__ void init(int M, int N, int G_, int c_) { asm volatile("" : "+s"(c_), "+s"(G_)); nM = M / BM; nN = N / BM; nwg = nM * nN; G = G_; c = c_; }
    __device__ bool next(int i, Unit& u) const {
        if (c < 0) return false;
        const long L = (long)i * G + c; if (L >= nwg) return false;
        int wgid = (int)L; { const int q = nwg / NXCD, r = nwg % NXCD, xcd = wgid % NXCD, off = wgid / NXCD; wgid = (xcd < r ? xcd * (q + 1) : r * (q + 1) + (xcd - r) * q) + off; }
        const int nig = WGM * nN, gid = wgid / nig, fm = gid * WGM, gsz = (nM - fm) < WGM ? (nM - fm) : WGM;
        u.pm = fm + ((wgid % nig) % gsz); u.pn = (wgid % nig) / gsz; return true;
    }
    __device__ __forceinline__ void a_ready(const Unit&) const {}
    __device__ __forceinline__ void done(const Unit&) const {}
};

template <class Epi, class Sched>
__device__ __forceinline__ void gemm_phase(LAS unsigned char* lds, const Gemm g, const Sched& S, const Epi& E) {
    int tid = threadIdx.x; asm volatile("" : "+v"(tid));
    const int wid = __builtin_amdgcn_readfirstlane(tid >> 6), lane = tid & 63, wr = wid >> 2, wc = wid & 3, fr = lane & 15, fq = lane >> 4;
    int K = g.K; asm volatile("" : "+s"(K)); const int nt = K / BK;
    unsigned voffA[2], voffB[2];
#pragma unroll
    for (int i = 0; i < 2; ++i) { int R, C; stage_rc(tid * 16 + i * 8192, R, C); const int Rb = Epi::PERM ? ((R & ~31) + perm32(R & 31)) : R;
        voffA[i] = (unsigned)(R * (g.blkA ? 64 : g.lda) + C) * 2u; voffB[i] = (unsigned)(Rb * (g.blkB ? 64 : g.ldb) + C) * 2u; }
    const size_t kstepA = g.blkA ? (size_t)32768 : (size_t)(BK * 2), kstepB = g.blkB ? (size_t)32768 : (size_t)(BK * 2);
    const size_t hstepA = (size_t)HALF * (g.blkA ? 64 : g.lda) * 2, hstepB = (size_t)HALF * (g.blkB ? 64 : g.ldb) * 2;
    const size_t tstepA = g.blkA ? (size_t)(g.K / 64) * 32768 : 2 * hstepA, tstepB = g.blkB ? (size_t)(g.K / 64) * 32768 : 2 * hstepB;
    const unsigned ldsw = (unsigned)wid * 1024u;
    const int aoff = lds_byte(wr * 64 + fr, fq * 8), boff = lds_byte(wc * 32 + fr, fq * 8);
#define PG8_SA(b, h) (((b) * 2 + (h)) * HTB)
#define PG8_SB(b, h) ((4 + (b) * 2 + (h)) * HTB)
#define PG8_STAGE(bufoff, gbase, voff) do { _Pragma("unroll") for (int _i = 0; _i < 2; ++_i) \
        __builtin_amdgcn_global_load_lds((const unsigned*)((const char*)(gbase) + (voff)[_i]), (LAS unsigned*)(lds + (bufoff) + ldsw + _i * 8192), 16, 0, 0); } while (0)
#define PG8_LDA(dst, b, h) do { _Pragma("unroll") for (int m = 0; m < 4; ++m) _Pragma("unroll") for (int k = 0; k < 2; ++k) dst[m][k] = *(const LAS bf16x8*)(lds + PG8_SA(b, h) + aoff + m * 2048 + k * 1024); } while (0)
#define PG8_LDB(dst, b, h) do { _Pragma("unroll") for (int n = 0; n < 2; ++n) _Pragma("unroll") for (int k = 0; k < 2; ++k) dst[n][k] = *(const LAS bf16x8*)(lds + PG8_SB(b, h) + boff + n * 2048 + k * 1024); } while (0)
#define PG8_MMA(ai, bj, At, Bt) do { __builtin_amdgcn_s_setprio(1); _Pragma("unroll") for (int m = 0; m < 4; ++m) _Pragma("unroll") for (int n = 0; n < 2; ++n) _Pragma("unroll") for (int k = 0; k < 2; ++k) \
        acc[ai][bj][m][n] = __builtin_amdgcn_mfma_f32_16x16x32_bf16(Bt[n][k], At[m][k], acc[ai][bj][m][n], 0, 0, 0); __builtin_amdgcn_s_setprio(0); } while (0)
#define PG8_WAIT_V(n) asm volatile("s_waitcnt vmcnt(" #n ")" ::: "memory")
#define PG8_WAIT_L(n) asm volatile("s_waitcnt lgkmcnt(" #n ")" ::: "memory")
#define PG8_BAR __builtin_amdgcn_s_barrier()
#define PG8_SCHED __builtin_amdgcn_sched_barrier(0)
    Unit cur, nxt; int ui = 0;
    if (!S.next(0, cur)) return;
    f32x4 acc[2][2][4][2];
#pragma unroll
    for (int a = 0; a < 2; ++a)
#pragma unroll
        for (int b = 0; b < 2; ++b)
#pragma unroll
            for (int m = 0; m < 4; ++m)
#pragma unroll
                for (int n = 0; n < 2; ++n) acc[a][b][m][n] = (f32x4){0.f, 0.f, 0.f, 0.f};
    bf16x8 At[4][2], B0[2][2], B1[2][2];
    const char* cA = (const char*)g.A + (size_t)cur.pm * tstepA; const char* cB = (const char*)g.Bt + (size_t)cur.pn * tstepB;
    S.a_ready(cur);
    PG8_STAGE(PG8_SB(0, 0), cB, voffB); PG8_STAGE(PG8_SA(0, 0), cA, voffA); PG8_STAGE(PG8_SB(0, 1), cB + hstepB, voffB); PG8_STAGE(PG8_SA(0, 1), cA + hstepA, voffA);
    if (wr == 1) PG8_BAR;
    PG8_WAIT_V(4); PG8_BAR;
    PG8_STAGE(PG8_SB(1, 0), cB + kstepB, voffB); PG8_STAGE(PG8_SA(1, 0), cA + kstepA, voffA); PG8_STAGE(PG8_SB(1, 1), cB + hstepB + kstepB, voffB);
    PG8_WAIT_V(6); PG8_BAR;
    for (;;) {
        const bool has_next = S.next(ui + 1, nxt);
        const char* nA = has_next ? (const char*)g.A + (size_t)nxt.pm * tstepA : cA; const char* nB = has_next ? (const char*)g.Bt + (size_t)nxt.pn * tstepB : cB;
        for (int t = 0; t < nt; t += 2) {
            const bool last = (t == nt - 2);
            const char* a1 = cA + (size_t)(t + 1) * kstepA;
            const char* a2 = last ? nA : cA + (size_t)(t + 2) * kstepA; const char* b2 = last ? nB : cB + (size_t)(t + 2) * kstepB;
            const char* a3 = a2 + kstepA; const char* b3 = b2 + kstepB;
            if (last && has_next) S.a_ready(nxt);
            PG8_LDB(B0, 0, 0); PG8_SCHED; PG8_LDA(At, 0, 0); PG8_STAGE(PG8_SA(1, 1), a1 + hstepA, voffA);
            PG8_WAIT_L(8); PG8_BAR; PG8_WAIT_L(0); PG8_MMA(0, 0, At, B0); PG8_BAR; PG8_SCHED;
            PG8_LDB(B1, 0, 1); PG8_STAGE(PG8_SB(0, 0), b2, voffB);
            PG8_BAR; PG8_WAIT_L(0); PG8_MMA(0, 1, At, B1); PG8_BAR;
            PG8_LDA(At, 0, 1); PG8_STAGE(PG8_SA(0, 0), a2, voffA);
            PG8_BAR; PG8_WAIT_L(0); PG8_MMA(1, 0, At, B0); PG8_BAR; PG8_SCHED;
            PG8_STAGE(PG8_SB(0, 1), b2 + hstepB, voffB);
            PG8_WAIT_V(6); PG8_BAR; PG8_MMA(1, 1, At, B1); PG8_BAR;
            PG8_LDB(B0, 1, 0); PG8_SCHED; PG8_LDA(At, 1, 0); PG8_STAGE(PG8_SA(0, 1), a2 + hstepA, voffA);
            PG8_WAIT_L(8); PG8_BAR; PG8_WAIT_L(0); PG8_MMA(0, 0, At, B0); PG8_BAR; PG8_SCHED;
            PG8_LDB(B1, 1, 1); PG8_STAGE(PG8_SB(1, 0), b3, voffB);
            PG8_BAR; PG8_WAIT_L(0); PG8_MMA(0, 1, At, B1); PG8_BAR;
            PG8_LDA(At, 1, 1); PG8_STAGE(PG8_SA(1, 0), a3, voffA);
            PG8_BAR; PG8_WAIT_L(0); PG8_MMA(1, 0, At, B0); PG8_BAR; PG8_SCHED;
            PG8_STAGE(PG8_SB(1, 1), b3 + hstepB, voffB);
            PG8_WAIT_V(6); PG8_BAR; PG8_MMA(1, 1, At, B1); PG8_BAR;
        }
        E(acc, cur, wr, wc, fr, fq); S.done(cur);
        if (!has_next) break;
#pragma unroll
        for (int a = 0; a < 2; ++a)
#pragma unroll
            for (int b = 0; b < 2; ++b)
#pragma unroll
                for (int m = 0; m < 4; ++m)
#pragma unroll
                    for (int n = 0; n < 2; ++n) acc[a][b][m][n] = (f32x4){0.f, 0.f, 0.f, 0.f};
        cur = nxt; cA = nA; cB = nB; ++ui;
    }
    PG8_WAIT_V(0);
    if (wr == 0) PG8_BAR;
    PG8_BAR;
#undef PG8_SA
#undef PG8_SB
#undef PG8_STAGE
#undef PG8_LDA
#undef PG8_LDB
#undef PG8_MMA
#undef PG8_WAIT_V
#undef PG8_WAIT_L
#undef PG8_BAR
#undef PG8_SCHED
}
}
using pg8::Unit; using pg8::Gemm; using pg8::StaticOrder; using pg8::gemm_phase; using pg8::HALF; using pg8::BM;
#define EPI_LOOP_ROWS for (int ai = 0; ai < 2; ++ai) for (int m = 0; m < 4; ++m)
__device__ __forceinline__ u32x4 pack8(const f32x4 a, const f32x4 b) { u32x4 w; w.x = pk2(a[0], a[1]); w.y = pk2(a[2], a[3]); w.z = pk2(b[0], b[1]); w.w = pk2(b[2], b[3]); return w; }

struct EpiInProj {
    static constexpr bool PERM = true;
    unsigned char* ws;
    __device__ __forceinline__ void operator()(const f32x4 (&acc)[2][2][4][2], const Unit& u, int wr, int wc, int fr, int fq) const {
        const int pn = u.pn;
#pragma unroll
        for (int ai = 0; ai < 2; ++ai)
#pragma unroll
            for (int m = 0; m < 4; ++m) {
                const int tok = u.pm * BM + ai * HALF + wr * 64 + m * 16 + fr; const int b = tok >> 12, t = tok & 4095;
#pragma unroll
                for (int bj = 0; bj < 2; ++bj) {
                    const int cb = bj * HALF + wc * 32 + 8 * fq;
                    const f32x4 v0 = acc[ai][bj][m][0], v1 = acc[ai][bj][m][1];
                    if (pn == 13) { if (cb < 40) { float* p = (float*)(ws + WS_SM) + (size_t)tok * 40 + cb; *(f32x4*)p = v0; *(f32x4*)(p + 4) = v1; } continue; }
                    bf16_t* dst;
                    if (pn <= 1) dst = (bf16_t*)(ws + WS_QN) + (size_t)tok * 512 + pn * 256 + cb;
                    else if (pn <= 4) { const int which = (pn - 2) * 2 + (cb >> 7);
                        const size_t base = which == 0 ? WS_KC : which == 1 ? WS_VC : which == 2 ? WS_KS : which == 3 ? WS_VS : which == 4 ? WS_KW : WS_VW;
                        const int c = cb & 127, g = c >> 6, d = c & 63;
                        dst = (bf16_t*)(ws + base) + ((size_t)(b * 2 + g) * SEQ + t) * 64 + d; }
                    else if (pn <= 6) { const int h = cb >> 6, d = cb & 63; dst = (bf16_t*)(ws + (pn == 5 ? WS_GQ : WS_GK)) + ((size_t)(b * 4 + h) * SEQ + t) * 64 + d; }
                    else if (pn <= 8) { const int c = (pn - 7) * 256 + cb, h = c >> 7, d = c & 127; dst = (bf16_t*)(ws + WS_GV) + ((size_t)(b * 4 + h) * SEQ + t) * 128 + d; }
                    else if (pn <= 10) dst = (bf16_t*)(ws + WS_GR) + (size_t)tok * 512 + (pn - 9) * 256 + cb;
                    else dst = (bf16_t*)(ws + WS_MQ) + (size_t)tok * 512 + (pn - 11) * 256 + cb;
                    *(u32x4*)dst = pack8(v0, v1);
                    asm volatile("" ::: "memory");
                }
            }
    }
};
struct EpiGates {
    static constexpr bool PERM = true;
    unsigned char* G; const float* bias;
    __device__ __forceinline__ void operator()(const f32x4 (&acc)[2][2][4][2], const Unit& u, int wr, int wc, int fr, int fq) const {
#pragma unroll
        for (int bj = 0; bj < 2; ++bj) {
            const int col = u.pn * BM + bj * HALF + wc * 32 + 8 * fq;
            const f32x4 b0 = *(const f32x4*)(bias + col), b1 = *(const f32x4*)(bias + col + 4);
#pragma unroll
            for (int ai = 0; ai < 2; ++ai)
#pragma unroll
                for (int m = 0; m < 4; ++m) {
                    const int row = u.pm * BM + ai * HALF + wr * 64 + m * 16 + fr;
                    const f32x4 v0 = acc[ai][bj][m][0] + b0, v1 = acc[ai][bj][m][1] + b1;
                    unsigned q[8];
#pragma unroll
                    for (int j = 0; j < 4; ++j) { q[j] = (unsigned)(sigmoidf_(v0[j]) * 255.0f + 0.5f); q[4 + j] = (unsigned)(sigmoidf_(v1[j]) * 255.0f + 0.5f); }
                    u32x2 w; w.x = q[0] | (q[1] << 8) | (q[2] << 16) | (q[3] << 24); w.y = q[4] | (q[5] << 8) | (q[6] << 16) | (q[7] << 24);
                    *(u32x2*)(G + (size_t)row * 3072 + col) = w; asm volatile("" ::: "memory");
                }
        }
    }
};
template <int MODE> struct EpiMerge {
    static constexpr bool PERM = true;
    bf16_t* merged; const unsigned char* G; int br;
    __device__ __forceinline__ void operator()(const f32x4 (&acc)[2][2][4][2], const Unit& u, int wr, int wc, int fr, int fq) const {
#pragma unroll
        for (int ai = 0; ai < 2; ++ai) {
            u32x2 gv[4][2]; u32x4 ov[4][2];
#pragma unroll
            for (int m = 0; m < 4; ++m)
#pragma unroll
                for (int bj = 0; bj < 2; ++bj) {
                    const int row = u.pm * BM + ai * HALF + wr * 64 + m * 16 + fr, col = u.pn * BM + bj * HALF + wc * 32 + 8 * fq;
                    gv[m][bj] = *(const u32x2*)(G + (size_t)row * 3072 + br * 1024 + col);
                    if (MODE == 1) ov[m][bj] = *(const u32x4*)(merged + (size_t)row * 1024 + col);
                }
#pragma unroll
            for (int m = 0; m < 4; ++m)
#pragma unroll
                for (int bj = 0; bj < 2; ++bj) {
                    const int row = u.pm * BM + ai * HALF + wr * 64 + m * 16 + fr, col = u.pn * BM + bj * HALF + wc * 32 + 8 * fq;
                    const u32x2 g2 = gv[m][bj];
                    f32x4 v0 = acc[ai][bj][m][0], v1 = acc[ai][bj][m][1];
                    const float ig = 1.0f / 255.0f;
                    v0[0] *= (float)(g2.x & 255u) * ig; v0[1] *= (float)((g2.x >> 8) & 255u) * ig; v0[2] *= (float)((g2.x >> 16) & 255u) * ig; v0[3] *= (float)(g2.x >> 24) * ig;
                    v1[0] *= (float)(g2.y & 255u) * ig; v1[1] *= (float)((g2.y >> 8) & 255u) * ig; v1[2] *= (float)((g2.y >> 16) & 255u) * ig; v1[3] *= (float)(g2.y >> 24) * ig;
                    if (MODE == 1) { const u32x4 o = ov[m][bj];
                        v0[0] += __uint_as_float(o.x << 16); v0[1] += __uint_as_float(o.x & 0xffff0000u); v0[2] += __uint_as_float(o.y << 16); v0[3] += __uint_as_float(o.y & 0xffff0000u);
                        v1[0] += __uint_as_float(o.z << 16); v1[1] += __uint_as_float(o.z & 0xffff0000u); v1[2] += __uint_as_float(o.w << 16); v1[3] += __uint_as_float(o.w & 0xffff0000u); }
                    *(u32x4*)(merged + (size_t)row * 1024 + col) = pack8(v0, v1);
                }
            asm volatile("" ::: "memory");
        }
    }
};
struct EpiResid {
    static constexpr bool PERM = false;
    const float* base; float* out;
    __device__ __forceinline__ void operator()(const f32x4 (&acc)[2][2][4][2], const Unit& u, int wr, int wc, int fr, int fq) const {
#pragma unroll
        for (int ai = 0; ai < 2; ++ai) {
            f32x4 bs[4][2][2];
#pragma unroll
            for (int m = 0; m < 4; ++m) {
                const size_t off = (size_t)(u.pm * BM + ai * HALF + wr * 64 + m * 16 + fr) * 1024 + u.pn * BM + wc * 32 + 4 * fq;
#pragma unroll
                for (int bj = 0; bj < 2; ++bj)
#pragma unroll
                    for (int n = 0; n < 2; ++n) bs[m][bj][n] = *(const f32x4*)(base + off + bj * HALF + n * 16);
            }
#pragma unroll
            for (int m = 0; m < 4; ++m) {
                const size_t off = (size_t)(u.pm * BM + ai * HALF + wr * 64 + m * 16 + fr) * 1024 + u.pn * BM + wc * 32 + 4 * fq;
#pragma unroll
                for (int bj = 0; bj < 2; ++bj)
#pragma unroll
                    for (int n = 0; n < 2; ++n) *(f32x4*)(out + off + bj * HALF + n * 16) = bs[m][bj][n] + acc[ai][bj][m][n];
            }
            asm volatile("" ::: "memory");
        }
    }
};
struct EpiRelu2 {
    static constexpr bool PERM = true;
    bf16_t* U;
    __device__ __forceinline__ void operator()(const f32x4 (&acc)[2][2][4][2], const Unit& u, int wr, int wc, int fr, int fq) const {
#pragma unroll
        for (int ai = 0; ai < 2; ++ai)
#pragma unroll
            for (int m = 0; m < 4; ++m) {
                const int row = u.pm * BM + ai * HALF + wr * 64 + m * 16 + fr;
#pragma unroll
                for (int bj = 0; bj < 2; ++bj) {
                    const int col = u.pn * BM + bj * HALF + wc * 32 + 8 * fq;
                    f32x4 v0 = acc[ai][bj][m][0], v1 = acc[ai][bj][m][1];
#pragma unroll
                    for (int j = 0; j < 4; ++j) { const float a = fmaxf(v0[j], 0.f), b = fmaxf(v1[j], 0.f); v0[j] = a * a; v1[j] = b * b; }
                    *(u32x4*)(U + ((size_t)((row >> 8) * 64 + (col >> 6)) * 256 + (row & 255)) * 64 + (col & 63)) = pack8(v0, v1);
                }
            }
    }
};
__device__ __forceinline__ float gelu_tanh(float x) { const float y = 0.7978845608028654f * (x + 0.044715f * x * x * x); const float e = __expf(2.0f * y); const float th = 1.0f - 2.0f * __builtin_amdgcn_rcpf(e + 1.0f); return 0.5f * x * (1.0f + th); }
struct EpiHid {
    static constexpr bool PERM = true;
    bf16_t* O; const float* bias;
    __device__ __forceinline__ void operator()(const f32x4 (&acc)[2][2][4][2], const Unit& u, int wr, int wc, int fr, int fq) const {
#pragma unroll
        for (int bj = 0; bj < 2; ++bj) {
            const int col = bj * HALF + wc * 32 + 8 * fq;
            const f32x4 b0 = *(const f32x4*)(bias + col), b1 = *(const f32x4*)(bias + col + 4);
#pragma unroll
            for (int ai = 0; ai < 2; ++ai)
#pragma unroll
                for (int m = 0; m < 4; ++m) {
                    const int row = u.pm * BM + ai * HALF + wr * 64 + m * 16 + fr;
                    f32x4 v0 = acc[ai][bj][m][0] + b0, v1 = acc[ai][bj][m][1] + b1;
#pragma unroll
                    for (int j = 0; j < 4; ++j) { v0[j] = gelu_tanh(v0[j]); v1[j] = gelu_tanh(v1[j]); }
                    *(u32x4*)(O + (size_t)row * 256 + col) = pack8(v0, v1); asm volatile("" ::: "memory");
                }
        }
    }
};
struct EpiPlain {
    static constexpr bool PERM = true;
    bf16_t* O; int ldc;
    __device__ __forceinline__ void operator()(const f32x4 (&acc)[2][2][4][2], const Unit& u, int wr, int wc, int fr, int fq) const {
#pragma unroll
        for (int ai = 0; ai < 2; ++ai)
#pragma unroll
            for (int m = 0; m < 4; ++m) {
                const int row = u.pm * BM + ai * HALF + wr * 64 + m * 16 + fr;
#pragma unroll
                for (int bj = 0; bj < 2; ++bj) { const int col = u.pn * BM + bj * HALF + wc * 32 + 8 * fq; *(u32x4*)(O + (size_t)row * ldc + col) = pack8(acc[ai][bj][m][0], acc[ai][bj][m][1]); }
            }
    }
};
struct Params {
    const float* in[23];
    float* out; unsigned char* ws;
    float inv_freq[8];
};
enum { I_X = 0, I_MEM, I_POS, I_LN_MIX, I_W_IN, I_B_MERGE, I_NQ_NORM, I_NK_NORM, I_CMP_PE, I_CMP_W1, I_CMP_W2, I_GLA_WG, I_GLA_BG, I_GLA_NORM,
       I_MEM_NORM, I_MEM_WKV, I_MEM_QN, I_MEM_KN, I_W_BRANCH, I_W_OUT, I_LN_MLP, I_W_UP, I_W_DOWN };

__device__ __forceinline__ int win_src_col(int n) {
    if (n < 1280) return n;
    if (n < 2816) return n + 24;
    if (n < 3328) return n + 40;
    if (n < 3352) return 1280 + (n - 3328);
    if (n < 3368) return 2840 + (n - 3352);
    if (n < 3584) return -1;
    return n - 216;
}
__device__ __forceinline__ void conv_block(const float* __restrict__ src, int ldsrc, bf16_t* __restrict__ dst, int K  , int n0, int k0, bool winmap, LAS float* tile) {
    const int tid = opq_tid();
    { const int n = tid & 63; const int sc = winmap ? win_src_col(n0 + n) : (n0 + n); const float* sp = src + (size_t)(k0 + (tid >> 6)) * ldsrc + (sc >= 0 ? sc : 0);
      float v[32];
#pragma unroll
      for (int i = 0; i < 32; ++i) v[i] = sp[(size_t)(8 * i) * ldsrc];
      __syncthreads();
#pragma unroll
      for (int i = 0; i < 32; ++i) tile[((tid >> 6) + 8 * i) * 65 + n] = sc >= 0 ? v[i] : 0.f; }
    __syncthreads();
    { const int kp = tid & 127;
#pragma unroll
      for (int i = 0; i < 16; ++i) { const int n2 = (tid >> 7) + 4 * i; const int n = n0 + n2, k = k0 + 2 * kp;
          const size_t di = K > 0 ? (size_t)n * K + k : ((size_t)((n >> 8) * (-K) + (k >> 6)) * 256 + (n & 255)) * 64 + (k & 63);
          *(unsigned*)(dst + di) = pk2(tile[(2 * kp) * 65 + n2], tile[(2 * kp + 1) * 65 + n2]); } }
}
__device__ __forceinline__ void phase_convert(const Params& p, int l, LAS unsigned char* lds, unsigned* ctr, LAS int* slot) {
    asm volatile("" : "+s"(l));
    LAS float* tile = (LAS float*)lds;
    unsigned char* ws = p.ws;
    for (;;) {
        __syncthreads(); if (opq_tid() == 0) *slot = (int)atomicAdd(ctr, 1u); __syncthreads();
        const int it = __builtin_amdgcn_readfirstlane(*slot); if (it >= 1216) break;
        int i = it; const float* src; bf16_t* dst; int K, ld, ntn; bool wm = false; int ldd = 0;
        if (i < 416) { src = p.in[I_W_IN] + (size_t)l * 1024 * DIN; dst = (bf16_t*)(ws + WS_WIN); K = 1024; ld = DIN; ntn = 104; wm = true; }
        else if ((i -= 416) < 96) { const int br = i / 32; i -= br * 32; src = p.in[I_W_BRANCH] + ((size_t)l * 3 + br) * 512 * 1024; dst = (bf16_t*)(ws + WS_WBR) + (size_t)br * 1024 * 512; K = 512; ld = 1024; ntn = 16; }
        else if ((i -= 96) < 64) { src = p.in[I_W_OUT] + (size_t)l * 1024 * 1024; dst = (bf16_t*)(ws + WS_WOUT); K = 1024; ld = 1024; ntn = 16; }
        else if ((i -= 64) < 256) { src = p.in[I_W_UP] + (size_t)l * 1024 * 4096; dst = (bf16_t*)(ws + WS_WUP); K = 1024; ld = 4096; ntn = 64; }
        else if ((i -= 256) < 256) { src = p.in[I_W_DOWN] + (size_t)l * 4096 * 1024; dst = (bf16_t*)(ws + WS_WDN2); K = 4096; ld = 1024; ntn = 16; ldd = -64; }
        else if ((i -= 256) < 64) { src = p.in[I_MEM_WKV] + (size_t)l * 1024 * 1024; dst = (bf16_t*)(ws + WS_WKV); K = 1024; ld = 1024; ntn = 16; }
        else { i -= 64; const int kv = i / 32; i -= kv * 32; src = p.in[I_CMP_W1] + ((size_t)l * 2 + kv) * 2048 * 256; dst = (bf16_t*)(ws + WS_W1) + (size_t)kv * 256 * 2048; K = 2048; ld = 256; ntn = 4; }
        const int tn = i % ntn, kg = i / ntn;
        conv_block(src, ld, dst, ldd ? ldd : K, tn * 64, kg * 256, wm, tile);
    }
    __syncthreads();
}
__device__ __forceinline__ void phase_bias1(const Params& p, int l, LAS unsigned char* lds) {
    asm volatile("" : "+s"(l));
    if (opq_bid() < opq_gdim() - 8) return;
    const int j = opq_bid() - (opq_gdim() - 8), kv = j >> 2, e0 = (j & 3) * 64;
    const int tid = opq_tid(), w = tid >> 6, lane = tid & 63;
    const float* pe = p.in[I_CMP_PE] + ((size_t)l * 2 + kv) * 2048; const float* W1 = p.in[I_CMP_W1] + ((size_t)l * 2 + kv) * 2048 * 256;
    float s = 0.f;
#pragma unroll 1
    for (int f0 = w * 256; f0 < w * 256 + 256; f0 += 16) {
        float pv[16], wv[16];
#pragma unroll
        for (int i = 0; i < 16; ++i) { pv[i] = pe[f0 + i]; wv[i] = W1[(size_t)(f0 + i) * 256 + e0 + lane]; }
#pragma unroll
        for (int i = 0; i < 16; ++i) s += pv[i] * wv[i];
    }
    LAS float* red = (LAS float*)lds;
    __syncthreads(); red[w * 64 + lane] = s; __syncthreads();
    if (w == 0) { float t = 0.f; for (int i = 0; i < 8; ++i) t += red[i * 64 + lane]; ((float*)(p.ws + WS_B1))[kv * 256 + e0 + lane] = t; }
    __syncthreads();
}
__device__ __forceinline__ float wave_sum(float v) {
#pragma unroll
    for (int o = 32; o >= 1; o >>= 1) v += __shfl_xor(v, o);
    return v;
}
__device__ __forceinline__ void phase_rmsnorm(const float* __restrict__ x, const float* __restrict__ g, bf16_t* __restrict__ out, int nrows) {
    const int lane = opq_tid() & 63; const int gw = opq_bid() * 8 + (opq_tid() >> 6), nw = opq_gdim() * 8;
    f32x4 gg[4];
#pragma unroll
    for (int i = 0; i < 4; ++i) gg[i] = ((const f32x4*)g)[lane + 64 * i];
    for (int r0 = gw; r0 < nrows; r0 += 4 * nw) {
        f32x4 v[4][4]; float ss[4];
#pragma unroll
        for (int k = 0; k < 4; ++k) { const int r = r0 + k * nw; const f32x4* xr = (const f32x4*)(x + (size_t)(r < nrows ? r : r0) * 1024);
#pragma unroll
            for (int i = 0; i < 4; ++i) v[k][i] = xr[lane + 64 * i]; }
#pragma unroll
        for (int k = 0; k < 4; ++k) { float s = 0.f;
#pragma unroll
            for (int i = 0; i < 4; ++i) s += v[k][i][0] * v[k][i][0] + v[k][i][1] * v[k][i][1] + v[k][i][2] * v[k][i][2] + v[k][i][3] * v[k][i][3];
            ss[k] = wave_sum(s); }
#pragma unroll
        for (int k = 0; k < 4; ++k) { const int r = r0 + k * nw; if (r < nrows) { const float rs = __builtin_amdgcn_rsqf(ss[k] * (1.0f / 1024.0f) + 1e-6f);
#pragma unroll
            for (int i = 0; i < 4; ++i) { u32x2 w; w.x = pk2(v[k][i][0] * rs * gg[i][0], v[k][i][1] * rs * gg[i][1]); w.y = pk2(v[k][i][2] * rs * gg[i][2], v[k][i][3] * rs * gg[i][3]);
                *(u32x2*)(out + (size_t)r * 1024 + (lane + 64 * i) * 4) = w; } } }
    }
}
__device__ __forceinline__ void phase_softmax_ref(const Params& p, int l) {
    if (opq_bid() != 0 || opq_tid() >= 64) return;
    const int lane = opq_tid();
    float gq = fabsf(p.in[I_NQ_NORM][l * 64 + lane]), gk0 = fabsf(p.in[I_NK_NORM][(l * 3 + 0) * 64 + lane]), gk1 = fabsf(p.in[I_NK_NORM][(l * 3 + 1) * 64 + lane]), gk2 = fabsf(p.in[I_NK_NORM][(l * 3 + 2) * 64 + lane]);
    float gmq = fmaxf(fabsf(p.in[I_MEM_QN][l * 128 + lane]), fabsf(p.in[I_MEM_QN][l * 128 + 64 + lane])), gmk = fmaxf(fabsf(p.in[I_MEM_KN][l * 128 + lane]), fabsf(p.in[I_MEM_KN][l * 128 + 64 + lane]));
#pragma unroll
    for (int o = 32; o >= 1; o >>= 1) { gq = fmaxf(gq, __shfl_xor(gq, o)); gk0 = fmaxf(gk0, __shfl_xor(gk0, o)); gk1 = fmaxf(gk1, __shfl_xor(gk1, o)); gk2 = fmaxf(gk2, __shfl_xor(gk2, o)); gmq = fmaxf(gmq, __shfl_xor(gmq, o)); gmk = fmaxf(gmk, __shfl_xor(gmk, o)); }
    float* CS = (float*)(p.ws + WS_CTL) + 128;
    const float qb = 8.0f * gq * 0.18033688011112042f * 1.001f;
    if (lane == 0) { CS[0] = -fminf(qb * 8.0f * gk0, 100.f); CS[1] = -fminf(qb * 8.0f * gk1, 100.f); CS[2] = -fminf(qb * 8.0f * gk2, 100.f);
        CS[3] = -fminf(11.313708f * gmq * 0.12751743082459868f * 11.313708f * gmk * 1.001f, 100.f); }
}
__device__ __forceinline__ void phase_rope_table(const Params& p) {
    float* tab = (float*)(p.ws + WS_ROPE); const int* pos = (const int*)p.in[I_POS];
    for (int i = opq_bid() * 512 + opq_tid(); i < NT * 8; i += opq_gdim() * 512) {
        const int tok = i >> 3, f = i & 7;
        float ifr = 0.f;
#pragma unroll
        for (int k = 0; k < 8; ++k) if (f == k) ifr = p.inv_freq[k];
        const float angf = (float)pos[tok] * ifr;
        double a = (double)angf; a -= 6.283185307179586 * rint(a * 0.15915494309189535);
        const float r = (float)a; tab[tok * 16 + f] = cosf(r); tab[tok * 16 + 8 + f] = sinf(r);
    }
}
template <bool PAIR, bool ROPE>
__device__ __forceinline__ void norm_vec64(bf16_t* ptr, const float* __restrict__ gain, const float* __restrict__ rt, float scale) {
    u32x4 raw[8]; float x[64];
#pragma unroll
    for (int i = 0; i < 8; ++i) raw[i] = ((const u32x4*)ptr)[i];
    float ss = 0.f;
#pragma unroll
    for (int i = 0; i < 8; ++i) {
        x[i * 8 + 0] = __uint_as_float(raw[i].x << 16); x[i * 8 + 1] = __uint_as_float(raw[i].x & 0xffff0000u);
        x[i * 8 + 2] = __uint_as_float(raw[i].y << 16); x[i * 8 + 3] = __uint_as_float(raw[i].y & 0xffff0000u);
        x[i * 8 + 4] = __uint_as_float(raw[i].z << 16); x[i * 8 + 5] = __uint_as_float(raw[i].z & 0xffff0000u);
        x[i * 8 + 6] = __uint_as_float(raw[i].w << 16); x[i * 8 + 7] = __uint_as_float(raw[i].w & 0xffff0000u);
    }
#pragma unroll
    for (int i = 0; i < 64; ++i) ss += x[i] * x[i];
    if (PAIR) ss += __shfl_xor(ss, 1);
    const float rstd = __builtin_amdgcn_rsqf(ss * (PAIR ? (1.0f / 128.0f) : (1.0f / 64.0f)) + 1e-6f);
#pragma unroll
    for (int i = 0; i < 64; ++i) x[i] = x[i] * rstd * gain[i];
    if (ROPE) {
#pragma unroll
        for (int i = 0; i < 8; ++i) { const float c = rt[i], s = rt[8 + i]; const float a = x[i], b = x[i + 8]; x[i] = a * c - b * s; x[i + 8] = b * c + a * s; }
    }
#pragma unroll
    for (int i = 0; i < 8; ++i) { u32x4 w; w.x = pk2(x[i * 8] * scale, x[i * 8 + 1] * scale); w.y = pk2(x[i * 8 + 2] * scale, x[i * 8 + 3] * scale);
        w.z = pk2(x[i * 8 + 4] * scale, x[i * 8 + 5] * scale); w.w = pk2(x[i * 8 + 6] * scale, x[i * 8 + 7] * scale); ((u32x4*)ptr)[i] = w; }
}
__device__ __forceinline__ void transpose64(const bf16_t* __restrict__ src, bf16_t* __restrict__ dst, LAS bf16_t* T) {
    const int tid = opq_tid(), r = tid >> 3, c8 = (tid & 7) * 8;
    const u32x4 v = *(const u32x4*)(src + r * 64 + c8);
    __syncthreads();
    T[(c8 + 0) * 72 + r] = (bf16_t)(v.x & 0xffff); T[(c8 + 1) * 72 + r] = (bf16_t)(v.x >> 16); T[(c8 + 2) * 72 + r] = (bf16_t)(v.y & 0xffff); T[(c8 + 3) * 72 + r] = (bf16_t)(v.y >> 16);
    T[(c8 + 4) * 72 + r] = (bf16_t)(v.z & 0xffff); T[(c8 + 5) * 72 + r] = (bf16_t)(v.z >> 16); T[(c8 + 6) * 72 + r] = (bf16_t)(v.w & 0xffff); T[(c8 + 7) * 72 + r] = (bf16_t)(v.w >> 16);
    __syncthreads();
    *(u32x4*)(dst + r * 64 + c8) = *(const LAS u32x4*)(T + r * 72 + c8);
}
__device__ __forceinline__ void postproc_item(const Params& p, int l, int item, LAS unsigned char* lds) {
    asm volatile("" : "+s"(l), "+s"(item));
    unsigned char* ws = p.ws; int tid = opq_tid(); asm volatile("" : "+v"(tid));
    const int b = item >> 6, blk = item & 63, tok0 = b * SEQ + blk * 64;
    const float* rope = (const float*)(ws + WS_ROPE);
    {
        const int tk = tid >> 3, h = tid & 7, tok = tok0 + tk;
        norm_vec64<false, true>((bf16_t*)(ws + WS_QN) + (size_t)tok * 512 + h * 64, p.in[I_NQ_NORM] + l * 64, rope + (size_t)tok * 16, 0.18033688011112042f);
    }
    {
        const int tk = tid >> 3, hh = tid & 7, tok = tok0 + tk;
        norm_vec64<true, false>((bf16_t*)(ws + WS_MQ) + (size_t)tok * 512 + hh * 64, p.in[I_MEM_QN] + l * 128 + (hh & 1) * 64, nullptr, 0.12751743082459868f);
    }
    if (tid < 256) {
        const int tk = tid >> 2, g = (tid >> 1) & 1, which = tid & 1, tok = tok0 + tk;
        bf16_t* base = (bf16_t*)(ws + (which ? WS_KW : WS_KS)) + ((size_t)(b * 2 + g) * SEQ + blk * 64 + tk) * 64;
        norm_vec64<false, true>(base, p.in[I_NK_NORM] + (l * 3 + 1 + which) * 64, rope + (size_t)tok * 16, 1.0f);
    }
    LAS bf16_t* T = (LAS bf16_t*)lds;
#pragma unroll 1
    for (int j = 0; j < 4; ++j) { const int g = j & 1, which = j >> 1; const size_t off = ((size_t)(b * 2 + g) * SEQ + blk * 64) * 64;
        transpose64((const bf16_t*)(ws + (which ? WS_VW : WS_VS)) + off, (bf16_t*)(ws + (which ? WS_VTW : WS_VTS)) + off, T); }
    __syncthreads();
}
__device__ __forceinline__ void phase_c2(const Params& p, int l, LAS unsigned char* lds_) {
    asm volatile("" : "+s"(l));
    unsigned char* ws = p.ws; const int lane = opq_tid() & 63; const int gw = opq_bid() * 8 + (opq_tid() >> 6), nw = opq_gdim() * 8;
    const bf16_t* HID = (const bf16_t*)(ws + WS_HID);
    bf16_t* KCMP = (bf16_t*)(ws + WS_KCMP); bf16_t* VCMPT = (bf16_t*)(ws + WS_VCMPT);
    const float* rope = (const float*)(ws + WS_ROPE);
    for (int wi = opq_bid(); wi < 256; wi += opq_gdim()) {
        const int kv = wi >> 7, bg = (wi >> 3) & 15, nb = (wi & 7) * 32;
        LAS float* W2s = (LAS float*)lds_; LAS bf16_t* Hs = (LAS bf16_t*)(lds_ + 65536);
        { const int tid = opq_tid(); const f32x4* W2g = (const f32x4*)(p.in[I_CMP_W2] + ((size_t)l * 2 + kv) * 256 * 64);
          const u32x4* Hg = (const u32x4*)(HID + ((size_t)kv * 4096 + bg * 256 + nb) * 256);
          f32x4 wv[8]; u32x4 hv[2];
#pragma unroll
          for (int i = 0; i < 8; ++i) wv[i] = W2g[tid + 512 * i];
#pragma unroll
          for (int i = 0; i < 2; ++i) hv[i] = Hg[tid + 512 * i];
          __syncthreads();
#pragma unroll
          for (int i = 0; i < 8; ++i) *(LAS f32x4*)(W2s + (tid + 512 * i) * 4) = wv[i];
#pragma unroll
          for (int i = 0; i < 2; ++i) *(LAS u32x4*)(Hs + (tid + 512 * i) * 8) = hv[i]; }
        __syncthreads();
        const int wv_ = opq_tid() >> 6; const int n0 = nb + wv_ * 4;
        const LAS bf16_t* hr = Hs + wv_ * 4 * 256;
        float a0 = 0.f, a1 = 0.f, a2 = 0.f, a3 = 0.f;
#pragma unroll 8
        for (int e = 0; e < 256; ++e) { const float w = W2s[e * 64 + lane]; a0 += bf2f(hr[e]) * w; a1 += bf2f(hr[256 + e]) * w; a2 += bf2f(hr[512 + e]) * w; a3 += bf2f(hr[768 + e]) * w; }
        float av[4] = {a0, a1, a2, a3};
#pragma unroll
        for (int r = 0; r < 4; ++r) {
            const int n = n0 + r; float v = av[r];
            if (kv == 0) {
                if (n < 255) {
                    const float ss = wave_sum(v * v); v = v / sqrtf(ss * (1.0f / 64.0f) + 1e-6f) * p.in[I_NK_NORM][(l * 3 + 0) * 64 + lane];
                    const int tok = (bg >> 1) * SEQ + 16 * n + 31; const float* rt = rope + (size_t)tok * 16;
                    const float oth = __shfl_xor(v, 8);
                    if (lane < 8) v = v * rt[lane] - oth * rt[8 + lane]; else if (lane < 16) v = v * rt[lane - 8] + oth * rt[lane];
                } else v = 0.f;
                KCMP[((size_t)bg * 256 + n) * 64 + lane] = f2bf(v);
            } else {
                if (n >= 255) v = 0.f;
                VCMPT[((size_t)bg * 64 + lane) * 256 + n] = f2bf(v);
            }
        }
    }
    const bf16_t* MKV = (const bf16_t*)(ws + WS_MKV); bf16_t* MK = (bf16_t*)(ws + WS_MK); bf16_t* MVT = (bf16_t*)(ws + WS_MVT);
    for (int it = gw; it < 8192; it += nw) {
        const int row = it >> 2, h = it & 3, b = row >> 8, m = row & 255;
        const unsigned kk = *(const unsigned*)(MKV + (size_t)row * 1024 + h * 128 + lane * 2);
        float k0 = __uint_as_float(kk << 16), k1 = __uint_as_float(kk & 0xffff0000u);
        const float ss = wave_sum(k0 * k0 + k1 * k1); const float rstd = __builtin_amdgcn_rsqf(ss * (1.0f / 128.0f) + 1e-6f);
        const float* gn = p.in[I_MEM_KN] + l * 128 + lane * 2;
        *(unsigned*)(MK + ((size_t)(b * 4 + h) * 256 + m) * 128 + lane * 2) = pk2(k0 * rstd * gn[0], k1 * rstd * gn[1]);
        const unsigned vv = *(const unsigned*)(MKV + (size_t)row * 1024 + 512 + h * 128 + lane * 2);
        bf16_t* vt = MVT + ((size_t)(b * 4 + h) * 128 + lane * 2) * 256 + m;
        vt[0] = (bf16_t)(vv & 0xffff); vt[256] = (bf16_t)(vv >> 16);
    }
}
#define MFMA16(a, b, c) __builtin_amdgcn_mfma_f32_16x16x32_bf16((a), (b), (c), 0, 0, 0)
template <int DH> struct KVRegs { u32x4 k[DH / 64], v[DH / 64]; };
template <int DH>
__device__ __forceinline__ void kv_load(KVRegs<DH>& r, const bf16_t* __restrict__ gK, int ldk, const bf16_t* __restrict__ gVt, int ldv) {
    const int tid = opq_tid();
#pragma unroll
    for (int i = 0; i < DH / 64; ++i) {
        const int idx = tid + i * 512; const int kr = idx / (DH / 8), kc = (idx % (DH / 8)) * 8;
        r.k[i] = *(const u32x4*)(gK + (size_t)kr * ldk + kc);
        const int vr = idx >> 3, vc = (idx & 7) * 8;
        r.v[i] = *(const u32x4*)(gVt + (size_t)vr * ldv + vc);
    }
}
template <int DH>
__device__ __forceinline__ void kv_store(const KVRegs<DH>& r, LAS bf16_t* Kt, LAS bf16_t* Vt) {
    const int tid = opq_tid();
#pragma unroll
    for (int i = 0; i < DH / 64; ++i) {
        const int idx = tid + i * 512; const int kr = idx / (DH / 8), kc = (idx % (DH / 8)) * 8;
        *(LAS u32x4*)(Kt + kr * (DH + 8) + kc) = r.k[i];
        const int vr = idx >> 3, vc = (idx & 7) * 8;
        *(LAS u32x4*)(Vt + vr * 72 + vc) = r.v[i];
    }
}
template <int DH>
__device__ __forceinline__ void qk_scores(const LAS bf16_t* Kt, const bf16x8 (&qf)[2][DH / 32], f32x4 (&st)[4][2], int fr, int fq, float c0) {
#pragma unroll
    for (int kt = 0; kt < 4; ++kt) {
        st[kt][0] = (f32x4){c0, c0, c0, c0}; st[kt][1] = (f32x4){c0, c0, c0, c0};
#pragma unroll
        for (int ks = 0; ks < DH / 32; ++ks) {
            const bf16x8 a = *(const LAS bf16x8*)(Kt + (kt * 16 + fr) * (DH + 8) + ks * 32 + fq * 8);
            st[kt][0] = MFMA16(a, qf[0][ks], st[kt][0]); st[kt][1] = MFMA16(a, qf[1][ks], st[kt][1]);
        }
    }
}
template <int DH> struct FlashState { float m[2], l[2]; f32x4 O[DH / 16][2]; };
template <int DH> __device__ __forceinline__ void flash_init(FlashState<DH>& s) {
    s.m[0] = s.m[1] = 0.f; s.l[0] = s.l[1] = 0.f;
#pragma unroll
    for (int d = 0; d < DH / 16; ++d) { s.O[d][0] = (f32x4){0.f, 0.f, 0.f, 0.f}; s.O[d][1] = (f32x4){0.f, 0.f, 0.f, 0.f}; }
}
template <int DH, bool FAST, bool HASOFF>
__device__ __forceinline__ void flash_step(const LAS bf16_t* Kt, const LAS bf16_t* Vt, const bf16x8 (&qf)[2][DH / 32], const u64 (&mask)[2], const float (&off)[2], FlashState<DH>& s, int fr, int fq, float cneg) {
    f32x4 st[4][2];
    qk_scores<DH>(Kt, qf, st, fr, fq, cneg);
    bf16x8 pb[2][2];
#pragma unroll
    for (int qt = 0; qt < 2; ++qt) {
        float ps = 0.f;
        if (FAST) {
#pragma unroll
            for (int kt = 0; kt < 4; ++kt)
#pragma unroll
                for (int j = 0; j < 4; ++j) { const float v = HASOFF ? st[kt][qt][j] + off[qt] : st[kt][qt][j]; const float pv = __builtin_amdgcn_exp2f(v); st[kt][qt][j] = pv; ps += pv; }
            s.l[qt] += ps;
        } else {
            const u64 msh = mask[qt] >> (fq * 4);
#pragma unroll
            for (int kt = 0; kt < 4; ++kt)
#pragma unroll
                for (int j = 0; j < 4; ++j) { const bool ok = (msh >> (kt * 16 + j)) & 1ull; const float pv = ok ? __builtin_amdgcn_exp2f(st[kt][qt][j]) : 0.f; st[kt][qt][j] = pv; ps += pv; }
            s.l[qt] += ps;
        }
#pragma unroll
        for (int kb = 0; kb < 2; ++kb) {
            u32x4 tw; tw.x = pk2(st[2 * kb][qt][0], st[2 * kb][qt][1]); tw.y = pk2(st[2 * kb][qt][2], st[2 * kb][qt][3]); tw.z = pk2(st[2 * kb + 1][qt][0], st[2 * kb + 1][qt][1]); tw.w = pk2(st[2 * kb + 1][qt][2], st[2 * kb + 1][qt][3]);
            const bf16x8 t = __builtin_bit_cast(bf16x8, tw);
            pb[kb][qt] = t;
        }
    }
#pragma unroll
    for (int d = 0; d < DH / 16; ++d)
#pragma unroll
        for (int kb = 0; kb < 2; ++kb) {
            const bf16x4 lo = *(const LAS bf16x4*)(Vt + (d * 16 + fr) * 72 + kb * 32 + fq * 4);
            const bf16x4 hi = *(const LAS bf16x4*)(Vt + (d * 16 + fr) * 72 + kb * 32 + 16 + fq * 4);
            const bf16x8 a = __builtin_shufflevector(lo, hi, 0, 1, 2, 3, 4, 5, 6, 7);
            s.O[d][0] = MFMA16(a, pb[kb][0], s.O[d][0]); s.O[d][1] = MFMA16(a, pb[kb][1], s.O[d][1]);
        }
}
__device__ __forceinline__ u64 low_mask(int n) { return n >= 63 ? ~0ull : (n < 0 ? 0ull : ((2ull << n) - 1ull)); }

template <int MODE  >
__device__ __forceinline__ void nsa_run(LAS unsigned char* lds, u64 blocks, const bf16_t* Kb, size_t kstr, int ldk, const bf16_t* Vb, size_t vstr, int ldv,
                                        const bf16x8 (&qf)[2][2], FlashState<64>& fs, int qi, const int (&tq)[2], const int (&qidx)[2], int fr, int fq, float cneg) {
    const LAS u64* sel = (const LAS u64*)(lds + 140288);
    if (blocks == 0ull) return;
    KVRegs<64> ra, rb;
    int j0 = __builtin_ctzll(blocks); blocks &= blocks - 1;
    kv_load<64>(ra, Kb + (size_t)j0 * kstr, ldk, Vb + (size_t)j0 * vstr, ldv);
    int j1 = -1;
    if (blocks != 0ull) { j1 = __builtin_ctzll(blocks); blocks &= blocks - 1; kv_load<64>(rb, Kb + (size_t)j1 * kstr, ldk, Vb + (size_t)j1 * vstr, ldv); }
    int par = 0;
    __syncthreads();
#define NSA_BLOCK(KT, VT, JC) do { \
        const int jc = (JC); u64 mask[2]; float off[2] = {0.f, 0.f}; \
        const bool fast = MODE == 0 ? (qi >= 1 && 64 * jc + 63 <= 4 * qi - 2) : (MODE == 1 ? jc != qi : (jc != qi && jc != qi - 8)); \
        if (fast) { \
            mask[0] = mask[1] = ~0ull; \
            if (MODE == 1) { off[0] = ((sel[qidx[0]] >> jc) & 1ull) ? 0.f : -1e30f; off[1] = ((sel[qidx[1]] >> jc) & 1ull) ? 0.f : -1e30f; } \
            flash_step<64, true, MODE == 1>(KT, VT, qf, mask, off, fs, fr, fq, cneg); \
        } else { \
            _Pragma("unroll") for (int qt = 0; qt < 2; ++qt) { \
                if (MODE == 0) { const int t = qi * 64 + tq[qt]; const int nlim = t >= 31 ? ((t - 31) >> 4) : -1; mask[qt] = low_mask(nlim - 64 * jc); } \
                else if (MODE == 1) { const u64 sm = sel[qidx[qt]]; mask[qt] = ((sm >> jc) & 1ull) ? (jc == qi ? low_mask(tq[qt]) : ~0ull) : 0ull; } \
                else { mask[qt] = jc == qi ? low_mask(tq[qt]) : (jc == qi - 8 ? ~low_mask(tq[qt]) : ~0ull); } \
            } \
            flash_step<64, false, false>(KT, VT, qf, mask, off, fs, fr, fq, cneg); \
        } } while (0)
    for (;;) {
        LAS bf16_t* Ka = (LAS bf16_t*)(lds + (par * 2) * 9216); LAS bf16_t* Kb2 = (LAS bf16_t*)(lds + (par * 2 + 1) * 9216);
        LAS bf16_t* Va = (LAS bf16_t*)(lds + 36864 + (par * 2) * 9216); LAS bf16_t* Vb2 = (LAS bf16_t*)(lds + 36864 + (par * 2 + 1) * 9216);
        const int ja = j0, jb = j1;
        kv_store<64>(ra, Ka, Va);
        if (jb >= 0) kv_store<64>(rb, Kb2, Vb2);
        __syncthreads();
        j0 = -1; j1 = -1;
        if (blocks != 0ull) { j0 = __builtin_ctzll(blocks); blocks &= blocks - 1; kv_load<64>(ra, Kb + (size_t)j0 * kstr, ldk, Vb + (size_t)j0 * vstr, ldv); }
        if (blocks != 0ull) { j1 = __builtin_ctzll(blocks); blocks &= blocks - 1; kv_load<64>(rb, Kb + (size_t)j1 * kstr, ldk, Vb + (size_t)j1 * vstr, ldv); }
        NSA_BLOCK(Ka, Va, ja);
        if (jb >= 0) NSA_BLOCK(Kb2, Vb2, jb);
        par ^= 1;
        if (j0 < 0) break;
    }
#undef NSA_BLOCK
}
__device__ __forceinline__ void nsa_item(const Params& p, int l, int item, LAS unsigned char* lds) {
    asm volatile("" : "+s"(l), "+s"(item));
    unsigned char* ws = p.ws;
    const int qi = 63 - (item >> 4), bg = item & 15, b = bg >> 1, g = bg & 1;
    int tid = opq_tid(); asm volatile("" : "+v"(tid));
    const int w = tid >> 6, lane = tid & 63, fr = lane & 15, fq = lane >> 4;
    const int r = w >> 1, h = g * 4 + r;
    int tq[2], qidx[2]; tq[0] = (w & 1) * 32 + fr; tq[1] = tq[0] + 16; qidx[0] = tq[0]; qidx[1] = tq[1];
    const int tok0 = b * SEQ + qi * 64;
    bf16_t* QN = (bf16_t*)(ws + WS_QN);
    bf16x8 qf[2][2];
#pragma unroll
    for (int qt = 0; qt < 2; ++qt)
#pragma unroll
        for (int ks = 0; ks < 2; ++ks) qf[qt][ks] = *(const bf16x8*)(QN + (size_t)(tok0 + tq[qt]) * 512 + h * 64 + ks * 32 + fq * 8);
    float cneg[3];
#pragma unroll
    for (int k = 0; k < 3; ++k) cneg[k] = ((const float*)(ws + WS_CTL))[128 + k];
    LAS float* imp = (LAS float*)(lds + 73728); LAS u64* sel = (LAS u64*)(lds + 140288);
    LAS float* finl = (LAS float*)(lds + 73728);
    FlashState<64> fs;
#define NSA_LTOT() do { _Pragma("unroll") for (int qt = 0; qt < 2; ++qt) { float lt = fs.l[qt]; lt += __shfl_xor(lt, 16); lt += __shfl_xor(lt, 32); fs.l[qt] = lt; } } while (0)
#define NSA_SC(k, qt) ({ const float gk_ = sigmoidf_(((const float*)(ws + WS_SM))[(size_t)(tok0 + tq[qt]) * 40 + h * 3 + (k)]); fs.l[qt] > 0.f ? gk_ / fs.l[qt] : 0.f; })
    const int ncb = ((4 * qi + 2) >> 6) + 1;
    const bf16_t* KC = (const bf16_t*)(ws + WS_KCMP) + (size_t)bg * 256 * 64; const bf16_t* VC = (const bf16_t*)(ws + WS_VCMPT) + (size_t)bg * 64 * 256;
    flash_init<64>(fs);
    nsa_run<0>(lds, (1ull << ncb) - 1ull, KC, 4096, 64, VC, 64, 256, qf, fs, qi, tq, qidx, fr, fq, cneg[0]);
    NSA_LTOT();
    if (qi >= 15) {
        LAS bf16_t* Kt0 = (LAS bf16_t*)lds;
        float inv[2]; inv[0] = fs.l[0] > 0.f ? 1.0f / fs.l[0] : 0.f; inv[1] = fs.l[1] > 0.f ? 1.0f / fs.l[1] : 0.f;
        float carry[2] = {0.f, 0.f};
        u32x4 kpre[4];
#pragma unroll
        for (int cb = 0; cb < 4; ++cb) if (cb < ncb) kpre[cb] = *(const u32x4*)(KC + (size_t)cb * 4096 + (tid >> 3) * 64 + (tid & 7) * 8);
#pragma unroll
        for (int cb = 0; cb < 4; ++cb) {
            if (cb >= ncb) break;
            { const int kr = tid >> 3, kc = (tid & 7) * 8; __syncthreads(); *(LAS u32x4*)(Kt0 + kr * 72 + kc) = kpre[cb]; __syncthreads(); }
            f32x4 st[4][2]; qk_scores<64>(Kt0, qf, st, fr, fq, cneg[0]);
#pragma unroll
            for (int qt = 0; qt < 2; ++qt) {
                const int t = qi * 64 + tq[qt]; const int nlim = (t - 31) >> 4;
#pragma unroll
                for (int kt = 0; kt < 4; ++kt) {
                    const int n0 = cb * 64 + kt * 16 + fq * 4; float pj[4];
#pragma unroll
                    for (int j = 0; j < 4; ++j) pj[j] = (n0 + j <= nlim) ? __builtin_amdgcn_exp2f(st[kt][qt][j] - fs.m[qt]) * inv[qt] : 0.f;
                    const float gs = (pj[0] + pj[1]) + (pj[2] + pj[3]);
                    const float up = __shfl(pj[3], (lane + 48) & 63);
                    const float prev = fq > 0 ? up : carry[qt];
                    if (fq == 0) carry[qt] = up;
                    imp[(r * 64 + qidx[qt]) * 65 + (n0 >> 2)] = gs + prev;
                }
            }
        }
        __syncthreads();
        for (int i = tid; i < 64 * 64; i += 512) { const int q = i >> 6, j = i & 63; if (j <= qi) imp[q * 65 + j] = (imp[q * 65 + j] + imp[(64 + q) * 65 + j]) + (imp[(128 + q) * 65 + j] + imp[(192 + q) * 65 + j]); }
        __syncthreads();
        {
            const int q = tid >> 3, sub = tid & 7; unsigned byte = 0u;
            float row[64];
#pragma unroll
            for (int k = 0; k < 64; ++k) { const float v = imp[q * 65 + k]; row[k] = k > qi ? -1e30f : ((k == 0 || k >= qi - 1) ? 1e4f : v); }
#pragma unroll 1
            for (int jj = 0; jj < 8; ++jj) {
                const int j = sub * 8 + jj; if (j > qi) break;
                const float sj = (j == 0 || j >= qi - 1) ? 1e4f : imp[q * 65 + j]; int rank = 0;
#pragma unroll
                for (int k = 0; k < 64; ++k) rank += (row[k] > sj || (row[k] == sj && k < j)) ? 1 : 0;
                if (rank < 16) byte |= 1u << jj;
            }
            ((LAS unsigned char*)sel)[q * 8 + sub] = (unsigned char)byte;
        }
    } else {
        if (tid < 64) sel[tid] = low_mask(qi);
    }
    __syncthreads();
    u64 uni;
    { u64 v = sel[lane]; unsigned lo = (unsigned)v, hi = (unsigned)(v >> 32);
#pragma unroll
      for (int o = 32; o >= 1; o >>= 1) { lo |= __shfl_xor(lo, o); hi |= __shfl_xor(hi, o); }
      uni = ((u64)(unsigned)__builtin_amdgcn_readfirstlane(hi) << 32) | (unsigned)__builtin_amdgcn_readfirstlane(lo); }
#pragma unroll
    for (int qt = 0; qt < 2; ++qt) { const float sc = NSA_SC(0, qt);
#pragma unroll
        for (int d = 0; d < 4; ++d)
#pragma unroll
            for (int r2 = 0; r2 < 4; ++r2) finl[((qt * 4 + d) * 4 + r2) * 512 + tid] = fs.O[d][qt][r2] * sc; }
    flash_init<64>(fs);
    nsa_run<1>(lds, uni & low_mask(qi), (const bf16_t*)(ws + WS_KS) + (size_t)bg * SEQ * 64, 4096, 64, (const bf16_t*)(ws + WS_VTS) + (size_t)bg * SEQ * 64, 4096, 64, qf, fs, qi, tq, qidx, fr, fq, cneg[1]);
    NSA_LTOT();
#pragma unroll
    for (int qt = 0; qt < 2; ++qt) { const float sc = NSA_SC(1, qt);
#pragma unroll
        for (int d = 0; d < 4; ++d)
#pragma unroll
            for (int r2 = 0; r2 < 4; ++r2) finl[((qt * 4 + d) * 4 + r2) * 512 + tid] += fs.O[d][qt][r2] * sc; }
    flash_init<64>(fs);
    { const int j0 = qi >= 8 ? qi - 8 : 0; const u64 wb = low_mask(qi) & ~(j0 > 0 ? low_mask(j0 - 1) : 0ull);
      nsa_run<2>(lds, wb, (const bf16_t*)(ws + WS_KW) + (size_t)bg * SEQ * 64, 4096, 64, (const bf16_t*)(ws + WS_VTW) + (size_t)bg * SEQ * 64, 4096, 64, qf, fs, qi, tq, qidx, fr, fq, cneg[2]); }
    NSA_LTOT();
#pragma unroll
    for (int qt = 0; qt < 2; ++qt) { const float sc = NSA_SC(2, qt);
#pragma unroll
        for (int d = 0; d < 4; ++d) { float v[4];
#pragma unroll
            for (int r2 = 0; r2 < 4; ++r2) v[r2] = finl[((qt * 4 + d) * 4 + r2) * 512 + tid] + fs.O[d][qt][r2] * sc;
            u32x2 o; o.x = pk2(v[0], v[1]); o.y = pk2(v[2], v[3]);
            *(u32x2*)(QN + (size_t)(tok0 + tq[qt]) * 512 + h * 64 + d * 16 + fq * 4) = o; } }
#undef NSA_LTOT
#undef NSA_SC
    __syncthreads();
}
__device__ __forceinline__ void mem_item(const Params& p, int item, LAS unsigned char* lds) {
    asm volatile("" : "+s"(item));
    unsigned char* ws = p.ws;
    const int qb = item & 15, bh = item >> 4, b = bh >> 2, h = bh & 3;
    int tid = opq_tid(); asm volatile("" : "+v"(tid));
    const int w = tid >> 6, lane = tid & 63, fr = lane & 15, fq = lane >> 4;
    bf16_t* MQ = (bf16_t*)(ws + WS_MQ);
    const int tokb = b * SEQ + qb * 256 + w * 32;
    bf16x8 qf[2][4];
#pragma unroll
    for (int qt = 0; qt < 2; ++qt)
#pragma unroll
        for (int ks = 0; ks < 4; ++ks) qf[qt][ks] = *(const bf16x8*)(MQ + (size_t)(tokb + qt * 16 + fr) * 512 + h * 128 + ks * 32 + fq * 8);
    const bf16_t* Kb = (const bf16_t*)(ws + WS_MK) + (size_t)bh * 256 * 128; const bf16_t* Vb = (const bf16_t*)(ws + WS_MVT) + (size_t)bh * 128 * 256;
    LAS bf16_t* Kt[2] = {(LAS bf16_t*)lds, (LAS bf16_t*)(lds + 17408)}; LAS bf16_t* Vt[2] = {(LAS bf16_t*)(lds + 34816), (LAS bf16_t*)(lds + 53248)};
    const float cmem = ((const float*)(ws + WS_CTL))[128 + 3];
    FlashState<128> fs; flash_init<128>(fs);
    KVRegs<128> r; kv_load<128>(r, Kb, 128, Vb, 256);
    u64 mask[2] = {~0ull, ~0ull}; const float off0[2] = {0.f, 0.f};
    __syncthreads();
#pragma unroll 1
    for (int j = 0; j < 4; ++j) {
        kv_store<128>(r, Kt[j & 1], Vt[j & 1]);
        __syncthreads();
        if (j < 3) kv_load<128>(r, Kb + (size_t)(j + 1) * 64 * 128, 128, Vb + (j + 1) * 64, 256);
        flash_step<128, true, false>(Kt[j & 1], Vt[j & 1], qf, mask, off0, fs, fr, fq, cmem);
    }
#pragma unroll
    for (int qt = 0; qt < 2; ++qt) {
        float lt = fs.l[qt]; lt += __shfl_xor(lt, 16); lt += __shfl_xor(lt, 32); const float sc = 1.0f / lt;
#pragma unroll
        for (int d = 0; d < 8; ++d) { const f32x4 o = fs.O[d][qt] * sc; u32x2 v; v.x = pk2(o[0], o[1]); v.y = pk2(o[2], o[3]);
            *(u32x2*)(MQ + (size_t)(tokb + qt * 16 + fr) * 512 + h * 128 + d * 16 + fq * 4) = v; }
    }
    __syncthreads();
}
template <int STAGE>
__device__ __forceinline__ void gla_chunk_item(const Params& p, int l, int item, LAS unsigned char* lds) {
    asm volatile("" : "+s"(l), "+s"(item));
    unsigned char* ws = p.ws;
    const int bh = item >> 6, b = bh >> 2, h = bh & 3, c = item & 63, t0 = c * 64;
    int tid = opq_tid();
    const int w = __builtin_amdgcn_readfirstlane(tid >> 6), lane = tid & 63, fr = lane & 15, fq = lane >> 4;
    LAS bf16_t* Qt = (LAS bf16_t*)lds; LAS bf16_t* Kt = (LAS bf16_t*)(lds + 9216); LAS bf16_t* Kht = (LAS bf16_t*)(lds + 18432); LAS bf16_t* At = (LAS bf16_t*)(lds + 27648);
    LAS bf16_t* Vt = (LAS bf16_t*)(lds + 36864); LAS bf16_t* St = (LAS bf16_t*)(lds + 55296); LAS float* segsum = (LAS float*)(lds + 73728);
    const int d = lane, seg = w;
    const float* SM = (const float*)(ws + WS_SM);
    const bf16_t* GQ = (const bf16_t*)(ws + WS_GQ) + (size_t)bh * SEQ * 64; const bf16_t* GK = (const bf16_t*)(ws + WS_GK) + (size_t)bh * SEQ * 64;
    const bf16_t* GV = (const bf16_t*)(ws + WS_GV) + (size_t)bh * SEQ * 128; bf16_t* GR = (bf16_t*)(ws + WS_GR);
    bf16_t* GS = (bf16_t*)(ws + WS_GS) + (size_t)item * 8192; float* EB = (float*)(ws + WS_EB) + (size_t)item * 64;
    float wg[16];
#pragma unroll
    for (int r = 0; r < 16; ++r) wg[r] = p.in[I_GLA_WG][((size_t)l * 16 + r) * 256 + h * 64 + d];
    const float bgv = p.in[I_GLA_BG][l * 256 + h * 64 + d];
    f32x4 gl4[8][4];
#pragma unroll
    for (int ii = 0; ii < 8; ++ii) { const float* gl = SM + (size_t)(b * SEQ + t0 + seg * 8 + ii) * 40 + 24;
#pragma unroll
        for (int r4 = 0; r4 < 4; ++r4) gl4[ii][r4] = *(const f32x4*)(gl + r4 * 4); }
    float qv[8], kv[8];
#pragma unroll
    for (int ii = 0; ii < 8; ++ii) { const size_t o = (size_t)(t0 + seg * 8 + ii) * 64 + d; if (STAGE == 3) qv[ii] = bf2f(GQ[o]); kv[ii] = bf2f(GK[o]); }
    u32x4 vraw[2], sraw[2];
#pragma unroll
    for (int pc = 0; pc < 2; ++pc) { const int idx = tid + pc * 512; vraw[pc] = *(const u32x4*)(GV + (size_t)(t0 + (tid & 63)) * 128 + ((tid >> 6) + 8 * pc) * 8);
        if (STAGE == 3) sraw[pc] = *(const u32x4*)(GS + (idx >> 3) * 64 + (idx & 7) * 8); }
    u32x2 rgraw[4];
    if (STAGE == 3) {
        const bf16_t* gp = GR + (size_t)(b * SEQ + t0 + (w & 3) * 16 + fr) * 512 + h * 128 + (w >> 2) * 64 + fq * 4;
#pragma unroll
        for (int vv = 0; vv < 4; ++vv) rgraw[vv] = *(const u32x2*)(gp + vv * 16);
    }
    float cs[8]; float run = 0.f;
#pragma unroll
    for (int ii = 0; ii < 8; ++ii) {
        float x = bgv;
#pragma unroll
        for (int r4 = 0; r4 < 4; ++r4) { const f32x4 gvv = gl4[ii][r4]; x += gvv[0] * wg[r4 * 4] + gvv[1] * wg[r4 * 4 + 1] + gvv[2] * wg[r4 * 4 + 2] + gvv[3] * wg[r4 * 4 + 3]; }
        const float ls = fminf(x, 0.f) - __logf(1.0f + __expf(-fabsf(x)));
        run += ls * (1.0f / 16.0f); cs[ii] = run;
    }
    segsum[seg * 64 + d] = run;
    __syncthreads();
    float pre = 0.f, tot = 0.f;
#pragma unroll
    for (int s2 = 0; s2 < 8; ++s2) { const float v = segsum[s2 * 64 + d]; tot += v; if (s2 < seg) pre += v; }
#pragma unroll
    for (int ii = 0; ii < 8; ++ii) {
        const int i = seg * 8 + ii; const float bi = pre + cs[ii];
        if (STAGE == 3) { Qt[i * 72 + d] = f2bf(qv[ii] * __expf(bi) * 0.125f); Kt[i * 72 + d] = f2bf(kv[ii] * __expf(-bi)); }
        else Kht[d * 72 + i] = f2bf(kv[ii] * __expf(tot - bi));
    }
    if (STAGE == 1 && seg == 0) EB[d] = __expf(tot);
#pragma unroll
    for (int pc = 0; pc < 2; ++pc) { const int idx = tid + pc * 512; const int i = tid & 63, v0 = ((tid >> 6) + 8 * pc) * 8; const u32x4 v = vraw[pc];
        Vt[(v0 + 0) * 72 + i] = (bf16_t)(v.x & 0xffff); Vt[(v0 + 1) * 72 + i] = (bf16_t)(v.x >> 16); Vt[(v0 + 2) * 72 + i] = (bf16_t)(v.y & 0xffff); Vt[(v0 + 3) * 72 + i] = (bf16_t)(v.y >> 16);
        Vt[(v0 + 4) * 72 + i] = (bf16_t)(v.z & 0xffff); Vt[(v0 + 5) * 72 + i] = (bf16_t)(v.z >> 16); Vt[(v0 + 6) * 72 + i] = (bf16_t)(v.w & 0xffff); Vt[(v0 + 7) * 72 + i] = (bf16_t)(v.w >> 16);
        if (STAGE == 3) *(LAS u32x4*)(St + (idx >> 3) * 72 + (idx & 7) * 8) = sraw[pc]; }
    __syncthreads();
    if (STAGE == 1) {
#pragma unroll
        for (int dt = 0; dt < 4; ++dt) {
            f32x4 acc = (f32x4){0.f, 0.f, 0.f, 0.f};
#pragma unroll
            for (int ks = 0; ks < 2; ++ks) { const bf16x8 a = *(const LAS bf16x8*)(Kht + (dt * 16 + fr) * 72 + ks * 32 + fq * 8); const bf16x8 bb = *(const LAS bf16x8*)(Vt + (w * 16 + fr) * 72 + ks * 32 + fq * 8); acc = MFMA16(a, bb, acc); }
            u32x2 o; o.x = pk2(acc[0], acc[1]); o.y = pk2(acc[2], acc[3]);
            *(u32x2*)(GS + (w * 16 + fr) * 64 + dt * 16 + fq * 4) = o;
        }
    } else {
        const int it = w & 3, vh = w >> 2;
        LAS bf16_t* Aw = vh ? (LAS bf16_t*)(lds + 75776) : At;
#pragma unroll
        for (int jt = 0; jt < 4; ++jt) {
            f32x4 a4 = (f32x4){0.f, 0.f, 0.f, 0.f};
            if (jt <= it) {
#pragma unroll
                for (int ks = 0; ks < 2; ++ks) { const bf16x8 a = *(const LAS bf16x8*)(Qt + (it * 16 + fr) * 72 + ks * 32 + fq * 8); const bf16x8 bb = *(const LAS bf16x8*)(Kt + (jt * 16 + fr) * 72 + ks * 32 + fq * 8); a4 = MFMA16(a, bb, a4); }
                if (jt == it) {
#pragma unroll
                    for (int r = 0; r < 4; ++r) if (fr > fq * 4 + r) a4[r] = 0.f;
                }
            }
#pragma unroll
            for (int r = 0; r < 4; ++r) Aw[(it * 16 + fq * 4 + r) * 72 + jt * 16 + fr] = f2bf(a4[r]);
        }
        f32x4 o[4];
#pragma unroll
        for (int vv = 0; vv < 4; ++vv) {
            const int vt = vh * 4 + vv;
            f32x4 acc = (f32x4){0.f, 0.f, 0.f, 0.f};
#pragma unroll
            for (int ks = 0; ks < 2; ++ks) { const bf16x8 a = *(const LAS bf16x8*)(Aw + (it * 16 + fr) * 72 + ks * 32 + fq * 8); const bf16x8 bb = *(const LAS bf16x8*)(Vt + (vt * 16 + fr) * 72 + ks * 32 + fq * 8); acc = MFMA16(bb, a, acc); }
#pragma unroll
            for (int ks = 0; ks < 2; ++ks) { const bf16x8 a = *(const LAS bf16x8*)(Qt + (it * 16 + fr) * 72 + ks * 32 + fq * 8); const bf16x8 bb = *(const LAS bf16x8*)(St + (vt * 16 + fr) * 72 + ks * 32 + fq * 8); acc = MFMA16(bb, a, acc); }
            o[vv] = acc;
        }
        float ss = 0.f;
#pragma unroll
        for (int vv = 0; vv < 4; ++vv) ss += (o[vv][0] * o[vv][0] + o[vv][1] * o[vv][1]) + (o[vv][2] * o[vv][2] + o[vv][3] * o[vv][3]);
        ss += __shfl_xor(ss, 16); ss += __shfl_xor(ss, 32);
        if (fq == 0) segsum[vh * 64 + it * 16 + fr] = ss;
        __syncthreads();
        ss = segsum[it * 16 + fr] + segsum[64 + it * 16 + fr];
        const float rstd = __builtin_amdgcn_rsqf(ss * (1.0f / 128.0f) + 1e-6f);
        bf16_t* gp = GR + (size_t)(b * SEQ + t0 + it * 16 + fr) * 512 + h * 128 + vh * 64 + fq * 4;
        const float* gnp = p.in[I_GLA_NORM] + l * 128 + vh * 64 + fq * 4;
#pragma unroll
        for (int vv = 0; vv < 4; ++vv) {
            const f32x4 gn4 = *(const f32x4*)(gnp + vv * 16); const u32x2 rr = rgraw[vv];
            const float g0 = __uint_as_float(rr.x << 16), g1 = __uint_as_float(rr.x & 0xffff0000u), g2 = __uint_as_float(rr.y << 16), g3 = __uint_as_float(rr.y & 0xffff0000u);
            u32x2 ov; ov.x = pk2(o[vv][0] * rstd * gn4[0] * g0 * sigmoidf_(g0), o[vv][1] * rstd * gn4[1] * g1 * sigmoidf_(g1));
            ov.y = pk2(o[vv][2] * rstd * gn4[2] * g2 * sigmoidf_(g2), o[vv][3] * rstd * gn4[3] * g3 * sigmoidf_(g3));
            *(u32x2*)(gp + vv * 16) = ov;
        }
    }
}
__device__ __forceinline__ void gla_scan(const Params& p) {
    unsigned char* ws = p.ws; bf16_t* GS = (bf16_t*)(ws + WS_GS); const float* EB = (const float*)(ws + WS_EB);
    for (int g = opq_bid() * 512 + opq_tid(); g < 32 * 4096; g += opq_gdim() * 512) {
        const int bh = g >> 12, e = (g & 4095) * 2, dd = e & 63;
        float s0 = 0.f, s1 = 0.f;
#pragma unroll 1
        for (int c0 = 0; c0 < 64; c0 += 8) {
            unsigned u[8]; float e0[8], e1[8];
#pragma unroll
            for (int k = 0; k < 8; ++k) { const size_t ch = (size_t)bh * 64 + c0 + k; u[k] = *(const unsigned*)(GS + ch * 8192 + e); const float2 ev = *(const float2*)(EB + ch * 64 + dd); e0[k] = ev.x; e1[k] = ev.y; }
#pragma unroll
            for (int k = 0; k < 8; ++k) { const size_t ch = (size_t)bh * 64 + c0 + k; *(unsigned*)(GS + ch * 8192 + e) = pk2(s0, s1);
                s0 = e0[k] * s0 + __uint_as_float(u[k] << 16); s1 = e1[k] * s1 + __uint_as_float(u[k] & 0xffff0000u); }
        }
    }
}
__device__ __forceinline__ int fetch_item(unsigned* ctr, LAS int* slot) {
    __syncthreads(); if (opq_tid() == 0) *slot = (int)atomicAdd(ctr, 1u); __syncthreads(); return __builtin_amdgcn_readfirstlane(*slot);
}
#define AS4 __attribute__((address_space(4)))
__device__ __forceinline__ void grid_barrier(unsigned* bar, unsigned& epoch) {
    asm volatile("s_waitcnt vmcnt(0) lgkmcnt(0)" ::: "memory");
    __syncthreads();
    epoch += (unsigned)opq_gdim();
    if (opq_tid() == 0) {
        __builtin_amdgcn_fence(__ATOMIC_RELEASE, "agent");
        __hip_atomic_fetch_add(bar, 1u, __ATOMIC_RELAXED, __HIP_MEMORY_SCOPE_AGENT);
        while (__hip_atomic_load(bar, __ATOMIC_RELAXED, __HIP_MEMORY_SCOPE_AGENT) < epoch) __builtin_amdgcn_s_sleep(1);
        __builtin_amdgcn_fence(__ATOMIC_ACQUIRE, "agent");
    }
    __syncthreads();
}
#define GRID_SYNC() grid_barrier((unsigned*)(kws_ + WS_CTL) + 64, epoch_)
#if defined(__HIP_DEVICE_COMPILE__)
#define PLOAD_ const Params p = *kp_;
#else
#define PLOAD_ const Params p = p_arg;
#endif
#define PH_BEGIN \
    const AS4 Params* kp_ = (const AS4 Params*)__builtin_amdgcn_kernarg_segment_ptr(); asm volatile("" : "+s"(kp_)); \
    PLOAD_ unsigned char* ws = p.ws; unsigned* ctl = (unsigned*)(ws + WS_CTL); (void)ctl; \
    int l = l_; asm volatile("" : "+s"(l)); \
    const int G = opq_gdim(), c = opq_bid(); (void)G; (void)c; \
    bf16_t* H = (bf16_t*)(ws + WS_H); bf16_t* HM = (bf16_t*)(ws + WS_HM); unsigned char* Gb = ws + WS_G; bf16_t* MG = (bf16_t*)(ws + WS_MERGED); bf16_t* U = (bf16_t*)(ws + WS_U); \
    const bf16_t* WIN = (const bf16_t*)(ws + WS_WIN); const float* xin = l == 0 ? p.in[I_X] : p.out; \
    (void)H; (void)HM; (void)Gb; (void)MG; (void)U; (void)WIN; (void)xin;
__global__ void __launch_bounds__(512, 2) fwd_kernel(Params p_arg) {
    extern __shared__ __attribute__((aligned(16))) unsigned char lds_raw[];
    LAS unsigned char* lds = (LAS unsigned char*)lds_raw;
    LAS int* slot = (LAS int*)(lds + LDS_BYTES - 16);
    cg::grid_group grid = cg::this_grid();
    unsigned char* kws_ = p_arg.ws; unsigned epoch_ = 0u;
#if defined(PRX)
    unsigned long long tacc0_ = 0ull, tacc1_ = 0ull, tprev_ = __builtin_amdgcn_s_memrealtime();
#define PROBE_MARK(id) do { const unsigned long long now_ = __builtin_amdgcn_s_memrealtime(); if ((id) == PRX) tacc0_ += now_ - tprev_; if ((id) == PRY) tacc1_ += now_ - tprev_; tprev_ = now_; } while (0)
#else
#define PROBE_MARK(id) do { } while (0)
#endif
    grid.sync();
#pragma unroll 1
    for (int l_ = 0; l_ < DEPTH; ++l_) {
#if !defined(ONLY) || ONLY == 0
        { PH_BEGIN
        if (l == 0) phase_rope_table(p);
        phase_bias1(p, l, lds);
        phase_convert(p, l, lds, ctl + l * 8 + 5, slot);
        phase_softmax_ref(p, l);
        phase_rmsnorm(xin, p.in[I_LN_MIX] + l * 1024, H, NT);
        phase_rmsnorm(p.in[I_MEM], p.in[I_MEM_NORM] + l * 1024, HM, 2048); }
        GRID_SYNC(); PROBE_MARK(0);
#endif
#if !defined(ONLY) || ONLY == 1
        { PH_BEGIN
        { StaticOrder S; S.init(NT, 3584, G, c); EpiInProj E{ws}; gemm_phase(lds, Gemm{H, WIN, NT, 3584, 1024, 1024, 1024, 0, 0}, S, E); }
        { StaticOrder S; S.init(NT, 3072, G, c); EpiGates E{Gb, p.in[I_B_MERGE] + l * 3072}; gemm_phase(lds, Gemm{H, WIN + (size_t)3584 * 1024, NT, 3072, 1024, 1024, 1024, 0, 0}, S, E); } }
        GRID_SYNC(); PROBE_MARK(1);
#endif
#if !defined(ONLY) || ONLY == 2
        { PH_BEGIN
        { StaticOrder S; S.init(4096, 256, G, c); EpiHid E{(bf16_t*)(ws + WS_HID), (const float*)(ws + WS_B1)}; gemm_phase(lds, Gemm{(const bf16_t*)(ws + WS_KC), (const bf16_t*)(ws + WS_W1), 4096, 256, 2048, 1024, 2048, 0, 0}, S, E); }
        { StaticOrder S; S.init(4096, 256, G, c - 16); EpiHid E{(bf16_t*)(ws + WS_HID) + (size_t)4096 * 256, (const float*)(ws + WS_B1) + 256}; gemm_phase(lds, Gemm{(const bf16_t*)(ws + WS_VC), (const bf16_t*)(ws + WS_W1) + (size_t)256 * 2048, 4096, 256, 2048, 1024, 2048, 0, 0}, S, E); }
        { StaticOrder S; S.init(2048, 1024, G, c - 32); EpiPlain E{(bf16_t*)(ws + WS_MKV), 1024}; gemm_phase(lds, Gemm{HM, (const bf16_t*)(ws + WS_WKV), 2048, 1024, 1024, 1024, 1024, 0, 0}, S, E); } }
        { PH_BEGIN
        for (;;) { const int it = fetch_item(ctl + l * 8 + 0, slot); if (it >= 512) break; postproc_item(p, l, it, lds); } }
        { PH_BEGIN
        for (;;) { const int it = fetch_item(ctl + l * 8 + 4, slot); if (it >= 2048) break; gla_chunk_item<1>(p, l, it, lds); } }
        GRID_SYNC(); PROBE_MARK(2);
#endif
#if !defined(ONLY) || ONLY == 3
        { PH_BEGIN
        phase_c2(p, l, lds); }
        { PH_BEGIN
        gla_scan(p); }
        GRID_SYNC(); PROBE_MARK(3);
#endif
#if !defined(ONLY) || ONLY == 4
        { PH_BEGIN
#pragma unroll 1
        for (int k = 0; k < 8; ++k) { const int xq = (c + k) & 7;
            for (;;) { const int i = fetch_item(ctl + 32 + l * 8 + xq, slot); if (i >= 128) break; nsa_item(p, l, (i & 63) * 16 + 2 * xq + (i >> 6), lds); } } }
        { PH_BEGIN
        for (;;) { const int it = fetch_item(ctl + l * 8 + 1, slot); if (it >= 2048) break; gla_chunk_item<3>(p, l, it, lds); } }
        { PH_BEGIN
        for (;;) { const int it = fetch_item(ctl + l * 8 + 3, slot); if (it >= 512) break; mem_item(p, it, lds); } }
        GRID_SYNC(); PROBE_MARK(4);
#endif
#if !defined(ONLY) || ONLY == 5
        { PH_BEGIN
        { StaticOrder S; S.init(NT, 1024, G, c); EpiMerge<0> E{MG, Gb, 0}; gemm_phase(lds, Gemm{(const bf16_t*)(ws + WS_QN), (const bf16_t*)(ws + WS_WBR), NT, 1024, 512, 512, 512, 0, 0}, S, E); }
        { StaticOrder S; S.init(NT, 1024, G, c); EpiMerge<1> E{MG, Gb, 1}; gemm_phase(lds, Gemm{(const bf16_t*)(ws + WS_GR), (const bf16_t*)(ws + WS_WBR) + (size_t)1024 * 512, NT, 1024, 512, 512, 512, 0, 0}, S, E); }
        { StaticOrder S; S.init(NT, 1024, G, c); EpiMerge<1> E{MG, Gb, 2}; gemm_phase(lds, Gemm{(const bf16_t*)(ws + WS_MQ), (const bf16_t*)(ws + WS_WBR) + (size_t)2048 * 512, NT, 1024, 512, 512, 512, 0, 0}, S, E); } }
        GRID_SYNC(); PROBE_MARK(5);
#endif
#if !defined(ONLY) || ONLY == 6
        { PH_BEGIN
        { StaticOrder S; S.init(NT, 1024, G, c); EpiResid E{xin, p.out}; gemm_phase(lds, Gemm{MG, (const bf16_t*)(ws + WS_WOUT), NT, 1024, 1024, 1024, 1024, 0, 0}, S, E); } }
        GRID_SYNC(); PROBE_MARK(6);
#endif
#if !defined(ONLY) || ONLY == 7
        { PH_BEGIN
        phase_rmsnorm(p.out, p.in[I_LN_MLP] + l * 1024, H, NT); }
        GRID_SYNC(); PROBE_MARK(7);
#endif
#if !defined(ONLY) || ONLY == 8
        { PH_BEGIN
        { StaticOrder S; S.init(NT, 4096, G, c); EpiRelu2 E{U}; gemm_phase(lds, Gemm{H, (const bf16_t*)(ws + WS_WUP), NT, 4096, 1024, 1024, 1024, 0, 0}, S, E); } }
        GRID_SYNC(); PROBE_MARK(8);
#endif
#if !defined(ONLY) || ONLY == 9
        { PH_BEGIN
        { StaticOrder S; S.init(NT, 1024, G, c); EpiResid E{p.out, p.out}; gemm_phase(lds, Gemm{U, (const bf16_t*)(ws + WS_WDN2), NT, 1024, 4096, 4096, 4096, 1, 1}, S, E); } }
        GRID_SYNC(); PROBE_MARK(9);
#endif
    }
#if defined(PRX)
    { const unsigned long long q0 = (tacc0_ + 5000ull) / 10000ull, q1 = (tacc1_ + 5000ull) / 10000ull; const unsigned long long dl = q0 * 1000000ull + q1 * 10000ull;
      const unsigned long long ts = __builtin_amdgcn_s_memrealtime(); while (__builtin_amdgcn_s_memrealtime() - ts < dl) __builtin_amdgcn_s_sleep(32); }
#endif
}

extern "C" void kernel_launch(void* const* d_in, const int* in_sizes, int n_in, void* d_out, int out_size, void* d_ws, size_t ws_size, hipStream_t stream) {
    static int grid = 0;
    if (grid == 0) {
        if (n_in != 23 || ws_size < WS_END) { fprintf(stderr, "kernel_launch: unexpected inputs (%d) or workspace (%zu < %zu)\n", n_in, ws_size, (size_t)WS_END); grid = -1; return; }
        int dev = 0, cus = 0, per_cu = 0;
        hipGetDevice(&dev); hipDeviceGetAttribute(&cus, hipDeviceAttributeMultiprocessorCount, dev);
        if (hipFuncSetAttribute((const void*)fwd_kernel, hipFuncAttributeMaxDynamicSharedMemorySize, LDS_BYTES) != hipSuccess) { fprintf(stderr, "kernel_launch: hipFuncSetAttribute failed\n"); grid = -1; return; }
        if (hipOccupancyMaxActiveBlocksPerMultiprocessor(&per_cu, (const void*)fwd_kernel, 512, LDS_BYTES) != hipSuccess || per_cu < 1) { fprintf(stderr, "kernel_launch: occupancy query says %d\n", per_cu); per_cu = 1; }
        (void)hipGetLastError();
        grid = cus * 1;
    }
    if (grid < 0) return;
    hipMemsetAsync((char*)d_ws + WS_CTL, 0, 4096, stream);
    Params p{};
    for (int i = 0; i < 23; ++i) p.in[i] = (const float*)d_in[i];
    p.out = (float*)d_out; p.ws = (unsigned char*)d_ws;
    for (int i = 0; i < 8; ++i) p.inv_freq[i] = powf(500000.0f, -(float)i / 8.0f);
    void* args[] = {&p};
    hipError_t e = hipLaunchCooperativeKernel((const void*)fwd_kernel, dim3(grid), dim3(512), args, LDS_BYTES, stream);
    if (e != hipSuccess) fprintf(stderr, "cooperative launch failed: %s (grid %d)\n", hipGetErrorString(e), grid);
}
```

```cpp
#include <hip/hip_runtime.h>
#include <hip/hip_cooperative_groups.h>
#include <cstdio>
#include <cmath>
namespace cg = cooperative_groups;
#define LAS __attribute__((address_space(3)))
typedef unsigned short bf16_t;
typedef short bf16x8 __attribute__((ext_vector_type(8)));
typedef short bf16x4 __attribute__((ext_vector_type(4)));
typedef float f32x4 __attribute__((ext_vector_type(4)));
typedef unsigned u32x4 __attribute__((ext_vector_type(4)));
typedef unsigned u32x2 __attribute__((ext_vector_type(2)));
typedef unsigned long long u64;

constexpr int NB = 8, SEQ = 4096, DM = 1024, NT = NB * SEQ, DEPTH = 4, DIN = 6440, NIN = 6656;
constexpr size_t MiB = 1048576;
constexpr size_t WS_CTL = 0;
constexpr size_t WS_ROPE = 4096;
constexpr size_t WS_WIN = WS_ROPE + 2 * MiB;
constexpr size_t WS_WBR = WS_WIN + 13 * MiB;
constexpr size_t WS_WOUT = WS_WBR + 3 * MiB;
constexpr size_t WS_WUP = WS_WOUT + 2 * MiB;
constexpr size_t WS_WDN = WS_WUP + 8 * MiB;
constexpr size_t WS_WKV = WS_WDN + 8 * MiB;
constexpr size_t WS_W1 = WS_WKV + 2 * MiB;
constexpr size_t WS_B1 = WS_W1 + 2 * MiB;
constexpr size_t WS_H = WS_B1 + 4096;
constexpr size_t WS_HM = WS_H + 64 * MiB;
constexpr size_t WS_QN = WS_HM + 4 * MiB;
constexpr size_t WS_KC = WS_QN + 32 * MiB;
constexpr size_t WS_VC = WS_KC + 8 * MiB;
constexpr size_t WS_KS = WS_VC + 8 * MiB;
constexpr size_t WS_KW = WS_KS + 8 * MiB;
constexpr size_t WS_VS = WS_KW + 8 * MiB;
constexpr size_t WS_VW = WS_VS + 8 * MiB;
constexpr size_t WS_VTS = WS_VW + 8 * MiB;
constexpr size_t WS_VTW = WS_VTS + 8 * MiB;
constexpr size_t WS_GQ = WS_VTW + 8 * MiB;
constexpr size_t WS_GK = WS_GQ + 16 * MiB;
constexpr size_t WS_GV = WS_GK + 16 * MiB;
constexpr size_t WS_GR = WS_GV + 32 * MiB;
constexpr size_t WS_MQ = WS_GR + 32 * MiB;
constexpr size_t WS_SM = WS_MQ + 32 * MiB;
constexpr size_t WS_G = WS_SM + 5 * MiB;
constexpr size_t WS_HID = WS_G + 96 * MiB;
constexpr size_t WS_KCMP = WS_HID + 4 * MiB;
constexpr size_t WS_VCMPT = WS_KCMP + MiB / 2;
constexpr size_t WS_MKV = WS_VCMPT + MiB / 2;
constexpr size_t WS_MK = WS_MKV + 4 * MiB;
constexpr size_t WS_MVT = WS_MK + 2 * MiB;
constexpr size_t WS_GS = WS_MVT + 2 * MiB;
constexpr size_t WS_EB = WS_GS + 32 * MiB;
constexpr size_t WS_WDN2 = WS_EB + MiB / 2;
constexpr size_t WS_END = WS_WDN2 + 9 * MiB;
constexpr int LDU = 4096 + 64;
constexpr size_t WS_MERGED = WS_KC;
constexpr size_t WS_U = WS_QN;
constexpr int LDS_BYTES = 147456;

__device__ __forceinline__ float bf2f(bf16_t b) { return __uint_as_float(((unsigned)b) << 16); }
__device__ __forceinline__ bf16_t f2bf(float f) { const __bf16 b = (__bf16)f; return __builtin_bit_cast(bf16_t, b); }
typedef float f32x2_t __attribute__((ext_vector_type(2)));
typedef __bf16 bf16x2_t __attribute__((ext_vector_type(2)));
__device__ __forceinline__ unsigned pk2(float lo, float hi) { const f32x2_t v = {lo, hi}; const bf16x2_t b = __builtin_convertvector(v, bf16x2_t); return __builtin_bit_cast(unsigned, b); }
__device__ __forceinline__ float sigmoidf_(float x) { return __builtin_amdgcn_rcpf(1.0f + __expf(-x)); }

__device__ __forceinline__ int opq_tid() { int t = threadIdx.x; asm volatile("" : "+v"(t)); return t; }
__device__ __forceinline__ int opq_bid() { int t = blockIdx.x; asm volatile("" : "+s"(t)); return t; }
__device__ __forceinline__ int opq_gdim() { int t = gridDim.x; asm volatile("" : "+s"(t)); return t; }
namespace pg8 {
constexpr int BM = 256, BK = 64, HALF = 128, HTB = HALF * BK * 2, STAGE_BYTES = 8 * HTB, NXCD = 8, WGM = 8;
__host__ __device__ __forceinline__ int lds_byte(int r, int c) { const int st = (r >> 4) * 2 + (c >> 5), rr = r & 15, cc = c & 31, ob = rr * 64 + cc * 2; return st * 1024 + (ob ^ (((ob >> 9) & 1) << 5)); }
__host__ __device__ __forceinline__ void stage_rc(int b, int& R, int& C) { const int st = b / 1024, sb = b % 1024, swz = sb ^ (((sb >> 9) & 1) << 5); R = (st >> 1) * 16 + swz / 64; C = (st & 1) * 32 + (swz % 64) / 2; }
__host__ __device__ __forceinline__ int perm32(int rho) { const int n = rho >> 4, i = rho & 15; return 8 * (i >> 2) + 4 * n + (i & 3); }
struct Unit { int pm, pn; };
struct Gemm { const bf16_t* A; const bf16_t* Bt; int M, N, K, lda, ldb; int blkA, blkB; };
struct StaticOrder {
    int nM, nN, nwg, G, c;
    __device__ void init(int M, int N, int G_, int c_) { asm volatile("" : "+s"(c_), "+s"(G_)); nM = M / BM; nN = N / BM; nwg = nM * nN; G = G_; c = c_; }
    __device__ bool next(int i, Unit& u) const {
        if (c < 0) return false;
        const long L = (long)i * G + c; if (L >= nwg) return false;
        int wgid = (int)L; { const int q = nwg / NXCD, r = nwg % NXCD, xcd = wgid % NXCD, off = wgid / NXCD; wgid = (xcd < r ? xcd * (q + 1) : r * (q + 1) + (xcd - r) * q) + off; }
        const int nig = WGM * nN, gid = wgid / nig, fm = gid * WGM, gsz = (nM - fm) < WGM ? (nM - fm) : WGM;
        u.pm = fm + ((wgid % nig) % gsz); u.pn = (wgid % nig) / gsz; return true;
    }
    __device__ __forceinline__ void a_ready(const Unit&) const {}
    __device__ __forceinline__ void done(const Unit&) const {}
};

template <class Epi, class Sched>
__device__ __forceinline__ void gemm_phase(LAS unsigned char* lds, const Gemm g, const Sched& S, const Epi& E) {
    int tid = threadIdx.x; asm volatile("" : "+v"(tid));
    const int wid = __builtin_amdgcn_readfirstlane(tid >> 6), lane = tid & 63, wr = wid >> 2, wc = wid & 3, fr = lane & 15, fq = lane >> 4;
    int K = g.K; asm volatile("" : "+s"(K)); const int nt = K / BK;
    unsigned voffA[2], voffB[2];
#pragma unroll
    for (int i = 0; i < 2; ++i) { int R, C; stage_rc(tid * 16 + i * 8192, R, C); const int Rb = Epi::PERM ? ((R & ~31) + perm32(R & 31)) : R;
        voffA[i] = (unsigned)(R * (g.blkA ? 64 : g.lda) + C) * 2u; voffB[i] = (unsigned)(Rb * (g.blkB ? 64 : g.ldb) + C) * 2u; }
    const size_t kstepA = g.blkA ? (size_t)32768 : (size_t)(BK * 2), kstepB = g.blkB ? (size_t)32768 : (size_t)(BK * 2);
    const size_t hstepA = (size_t)HALF * (g.blkA ? 64 : g.lda) * 2, hstepB = (size_t)HALF * (g.blkB ? 64 : g.ldb) * 2;
    const size_t tstepA = g.blkA ? (size_t)(g.K / 64) * 32768 : 2 * hstepA, tstepB = g.blkB ? (size_t)(g.K / 64) * 32768 : 2 * hstepB;
    const unsigned ldsw = (unsigned)wid * 1024u;
    const int aoff = lds_byte(wr * 64 + fr, fq * 8), boff = lds_byte(wc * 32 + fr, fq * 8);
#define PG8_SA(b, h) (((b) * 2 + (h)) * HTB)
#define PG8_SB(b, h) ((4 + (b) * 2 + (h)) * HTB)
#define PG8_STAGE(bufoff, gbase, voff) do { _Pragma("unroll") for (int _i = 0; _i < 2; ++_i) \
        __builtin_amdgcn_global_load_lds((const unsigned*)((const char*)(gbase) + (voff)[_i]), (LAS unsigned*)(lds + (bufoff) + ldsw + _i * 8192), 16, 0, 0); } while (0)
#define PG8_LDA(dst, b, h) do { _Pragma("unroll") for (int m = 0; m < 4; ++m) _Pragma("unroll") for (int k = 0; k < 2; ++k) dst[m][k] = *(const LAS bf16x8*)(lds + PG8_SA(b, h) + aoff + m * 2048 + k * 1024); } while (0)
#define PG8_LDB(dst, b, h) do { _Pragma("unroll") for (int n = 0; n < 2; ++n) _Pragma("unroll") for (int k = 0; k < 2; ++k) dst[n][k] = *(const LAS bf16x8*)(lds + PG8_SB(b, h) + boff + n * 2048 + k * 1024); } while (0)
#define PG8_MMA(ai, bj, At, Bt) do { __builtin_amdgcn_s_setprio(1); _Pragma("unroll") for (int m = 0; m < 4; ++m) _Pragma("unroll") for (int n = 0; n < 2; ++n) _Pragma("unroll") for (int k = 0; k < 2; ++k) \
        acc[ai][bj][m][n] = __builtin_amdgcn_mfma_f32_16x16x32_bf16(Bt[n][k], At[m][k], acc[ai][bj][m][n], 0, 0, 0); __builtin_amdgcn_s_setprio(0); } while (0)
#define PG8_WAIT_V(n) asm volatile("s_waitcnt vmcnt(" #n ")" ::: "memory")
#define PG8_WAIT_L(n) asm volatile("s_waitcnt lgkmcnt(" #n ")" ::: "memory")
#define PG8_BAR __builtin_amdgcn_s_barrier()
#define PG8_SCHED __builtin_amdgcn_sched_barrier(0)
    Unit cur, nxt; int ui = 0;
    if (!S.next(0, cur)) return;
    f32x4 acc[2][2][4][2];
#pragma unroll
    for (int a = 0; a < 2; ++a)
#pragma unroll
        for (int b = 0; b < 2; ++b)
#pragma unroll
            for (int m = 0; m < 4; ++m)
#pragma unroll
                for (int n = 0; n < 2; ++n) acc[a][b][m][n] = (f32x4){0.f, 0.f, 0.f, 0.f};
    bf16x8 At[4][2], B0[2][2], B1[2][2];
    const char* cA = (const char*)g.A + (size_t)cur.pm * tstepA; const char* cB = (const char*)g.Bt + (size_t)cur.pn * tstepB;
    S.a_ready(cur);
    PG8_STAGE(PG8_SB(0, 0), cB, voffB); PG8_STAGE(PG8_SA(0, 0), cA, voffA); PG8_STAGE(PG8_SB(0, 1), cB + hstepB, voffB); PG8_STAGE(PG8_SA(0, 1), cA + hstepA, voffA);
    if (wr == 1) PG8_BAR;
    PG8_WAIT_V(4); PG8_BAR;
    PG8_STAGE(PG8_SB(1, 0), cB + kstepB, voffB); PG8_STAGE(PG8_SA(1, 0), cA + kstepA, voffA); PG8_STAGE(PG8_SB(1, 1), cB + hstepB + kstepB, voffB);
    PG8_WAIT_V(6); PG8_BAR;
    for (;;) {
        const bool has_next = S.next(ui + 1, nxt);
        const char* nA = has_next ? (const char*)g.A + (size_t)nxt.pm * tstepA : cA; const char* nB = has_next ? (const char*)g.Bt + (size_t)nxt.pn * tstepB : cB;
        for (int t = 0; t < nt; t += 2) {
            const bool last = (t == nt - 2);
            const char* a1 = cA + (size_t)(t + 1) * kstepA;
            const char* a2 = last ? nA : cA + (size_t)(t + 2) * kstepA; const char* b2 = last ? nB : cB + (size_t)(t + 2) * kstepB;
            const char* a3 = a2 + kstepA; const char* b3 = b2 + kstepB;
            if (last && has_next) S.a_ready(nxt);
            PG8_LDB(B0, 0, 0); PG8_SCHED; PG8_LDA(At, 0, 0); PG8_STAGE(PG8_SA(1, 1), a1 + hstepA, voffA);
            PG8_WAIT_L(8); PG8_BAR; PG8_WAIT_L(0); PG8_MMA(0, 0, At, B0); PG8_BAR; PG8_SCHED;
            PG8_LDB(B1, 0, 1); PG8_STAGE(PG8_SB(0, 0), b2, voffB);
            PG8_BAR; PG8_WAIT_L(0); PG8_MMA(0, 1, At, B1); PG8_BAR;
            PG8_LDA(At, 0, 1); PG8_STAGE(PG8_SA(0, 0), a2, voffA);
            PG8_BAR; PG8_WAIT_L(0); PG8_MMA(1, 0, At, B0); PG8_BAR; PG8_SCHED;
            PG8_STAGE(PG8_SB(0, 1), b2 + hstepB, voffB);
            PG8_WAIT_V(6); PG8_BAR; PG8_MMA(1, 1, At, B1); PG8_BAR;
            PG8_LDB(B0, 1, 0); PG8_SCHED; PG8_LDA(At, 1, 0); PG8_STAGE(PG8_SA(0, 1), a2 + hstepA, voffA);
            PG8_WAIT_L(8); PG8_BAR; PG8_WAIT_L(0); PG8_MMA(0, 0, At, B0); PG8_BAR; PG8_SCHED;
            PG8_LDB(B1, 1, 1); PG8_STAGE(PG8_SB(1, 0), b3, voffB);
            PG8_BAR; PG8_WAIT_L(0); PG8_MMA(0, 1, At, B1); PG8_BAR;
            PG8_LDA(At, 1, 1); PG8_STAGE(PG8_SA(1, 0), a3, voffA);
            PG8_BAR; PG8_WAIT_L(0); PG8_MMA(1, 0, At, B0); PG8_BAR; PG8_SCHED;
            PG8_STAGE(PG8_SB(1, 1), b3 + hstepB, voffB);
            PG8_WAIT_V(6); PG8_BAR; PG8_MMA(1, 1, At, B1); PG8_BAR;
        }
        E(acc, cur, wr, wc, fr, fq); S.done(cur);
        if (!has_next) break;
#pragma unroll
        for (int a = 0; a < 2; ++a)
#pragma unroll
            for (int b = 0; b < 2; ++b)
#pragma unroll
                for (int m = 0; m < 4; ++m)
#pragma unroll
                    for (int n = 0; n < 2; ++n) acc[a][b][m][n] = (f32x4){0.f, 0.f, 0.f, 0.f};
        cur = nxt; cA = nA; cB = nB; ++ui;
    }
    PG8_WAIT_V(0);
    if (wr == 0) PG8_BAR;
    PG8_BAR;
#undef PG8_SA
#undef PG8_SB
#undef PG8_STAGE
#undef PG8_LDA
#undef PG8_LDB
#undef PG8_MMA
#undef PG8_WAIT_V
#undef PG8_WAIT_L
#undef PG8_BAR
#undef PG8_SCHED
}
}
using pg8::Unit; using pg8::Gemm; using pg8::StaticOrder; using pg8::gemm_phase; using pg8::HALF; using pg8::BM;
#define EPI_LOOP_ROWS for (int ai = 0; ai < 2; ++ai) for (int m = 0; m < 4; ++m)
__device__ __forceinline__ u32x4 pack8(const f32x4 a, const f32x4 b) { u32x4 w; w.x = pk2(a[0], a[1]); w.y = pk2(a[2], a[3]); w.z = pk2(b[0], b[1]); w.w = pk2(b[2], b[3]); return w; }

struct EpiInProj {
    static constexpr bool PERM = true;
    unsigned char* ws;
    __device__ __forceinline__ void operator()(const f32x4 (&acc)[2][2][4][2], const Unit& u, int wr, int wc, int fr, int fq) const {
        const int pn = u.pn;
#pragma unroll
        for (int ai = 0; ai < 2; ++ai)
#pragma unroll
            for (int m = 0; m < 4; ++m) {
                const int tok = u.pm * BM + ai * HALF + wr * 64 + m * 16 + fr; const int b = tok >> 12, t = tok & 4095;
#pragma unroll
                for (int bj = 0; bj < 2; ++bj) {
                    const int cb = bj * HALF + wc * 32 + 8 * fq;
                    const f32x4 v0 = acc[ai][bj][m][0], v1 = acc[ai][bj][m][1];
                    if (pn == 13) { if (cb < 40) { float* p = (float*)(ws + WS_SM) + (size_t)tok * 40 + cb; *(f32x4*)p = v0; *(f32x4*)(p + 4) = v1; } continue; }
                    bf16_t* dst;
                    if (pn <= 1) dst = (bf16_t*)(ws + WS_QN) + (size_t)tok * 512 + pn * 256 + cb;
                    else if (pn <= 4) { const int which = (pn - 2) * 2 + (cb >> 7);
                        const size_t base = which == 0 ? WS_KC : which == 1 ? WS_VC : which == 2 ? WS_KS : which == 3 ? WS_VS : which == 4 ? WS_KW : WS_VW;
                        const int c = cb & 127, g = c >> 6, d = c & 63;
                        dst = (bf16_t*)(ws + base) + ((size_t)(b * 2 + g) * SEQ + t) * 64 + d; }
                    else if (pn <= 6) { const int h = cb >> 6, d = cb & 63; dst = (bf16_t*)(ws + (pn == 5 ? WS_GQ : WS_GK)) + ((size_t)(b * 4 + h) * SEQ + t) * 64 + d; }
                    else if (pn <= 8) { const int c = (pn - 7) * 256 + cb, h = c >> 7, d = c & 127; dst = (bf16_t*)(ws + WS_GV) + ((size_t)(b * 4 + h) * SEQ + t) * 128 + d; }
                    else if (pn <= 10) dst = (bf16_t*)(ws + WS_GR) + (size_t)tok * 512 + (pn - 9) * 256 + cb;
                    else dst = (bf16_t*)(ws + WS_MQ) + (size_t)tok * 512 + (pn - 11) * 256 + cb;
                    *(u32x4*)dst = pack8(v0, v1);
                    asm volatile("" ::: "memory");
                }
            }
    }
};
struct EpiGates {
    static constexpr bool PERM = true;
    unsigned char* G; const float* bias;
    __device__ __forceinline__ void operator()(const f32x4 (&acc)[2][2][4][2], const Unit& u, int wr, int wc, int fr, int fq) const {
#pragma unroll
        for (int bj = 0; bj < 2; ++bj) {
            const int col = u.pn * BM + bj * HALF + wc * 32 + 8 * fq;
            const f32x4 b0 = *(const f32x4*)(bias + col), b1 = *(const f32x4*)(bias + col + 4);
#pragma unroll
            for (int ai = 0; ai < 2; ++ai)
#pragma unroll
                for (int m = 0; m < 4; ++m) {
                    const int row = u.pm * BM + ai * HALF + wr * 64 + m * 16 + fr;
                    const f32x4 v0 = acc[ai][bj][m][0] + b0, v1 = acc[ai][bj][m][1] + b1;
                    unsigned q[8];
#pragma unroll
                    for (int j = 0; j < 4; ++j) { q[j] = (unsigned)(sigmoidf_(v0[j]) * 255.0f + 0.5f); q[4 + j] = (unsigned)(sigmoidf_(v1[j]) * 255.0f + 0.5f); }
                    u32x2 w; w.x = q[0] | (q[1] << 8) | (q[2] << 16) | (q[3] << 24); w.y = q[4] | (q[5] << 8) | (q[6] << 16) | (q[7] << 24);
                    *(u32x2*)(G + (size_t)row * 3072 + col) = w; asm volatile("" ::: "memory");
                }
        }
    }
};
template <int MODE> struct EpiMerge {
    static constexpr bool PERM = true;
    bf16_t* merged; const unsigned char* G; int br;
    __device__ __forceinline__ void operator()(const f32x4 (&acc)[2][2][4][2], const Unit& u, int wr, int wc, int fr, int fq) const {
#pragma unroll
        for (int ai = 0; ai < 2; ++ai) {
            u32x2 gv[4][2]; u32x4 ov[4][2];
#pragma unroll
            for (int m = 0; m < 4; ++m)
#pragma unroll
                for (int bj = 0; bj < 2; ++bj) {
                    const int row = u.pm * BM + ai * HALF + wr * 64 + m * 16 + fr, col = u.pn * BM + bj * HALF + wc * 32 + 8 * fq;
                    gv[m][bj] = *(const u32x2*)(G + (size_t)row * 3072 + br * 1024 + col);
                    if (MODE == 1) ov[m][bj] = *(const u32x4*)(merged + (size_t)row * 1024 + col);
                }
#pragma unroll
            for (int m = 0; m < 4; ++m)
#pragma unroll
                for (int bj = 0; bj < 2; ++bj) {
                    const int row = u.pm * BM + ai * HALF + wr * 64 + m * 16 + fr, col = u.pn * BM + bj * HALF + wc * 32 + 8 * fq;
                    const u32x2 g2 = gv[m][bj];
                    f32x4 v0 = acc[ai][bj][m][0], v1 = acc[ai][bj][m][1];
                    const float ig = 1.0f / 255.0f;
                    v0[0] *= (float)(g2.x & 255u) * ig; v0[1] *= (float)((g2.x >> 8) & 255u) * ig; v0[2] *= (float)((g2.x >> 16) & 255u) * ig; v0[3] *= (float)(g2.x >> 24) * ig;
                    v1[0] *= (float)(g2.y & 255u) * ig; v1[1] *= (float)((g2.y >> 8) & 255u) * ig; v1[2] *= (float)((g2.y >> 16) & 255u) * ig; v1[3] *= (float)(g2.y >> 24) * ig;
                    if (MODE == 1) { const u32x4 o = ov[m][bj];
                        v0[0] += __uint_as_float(o.x << 16); v0[1] += __uint_as_float(o.x & 0xffff0000u); v0[2] += __uint_as_float(o.y << 16); v0[3] += __uint_as_float(o.y & 0xffff0000u);
                        v1[0] += __uint_as_float(o.z << 16); v1[1] += __uint_as_float(o.z & 0xffff0000u); v1[2] += __uint_as_float(o.w << 16); v1[3] += __uint_as_float(o.w & 0xffff0000u); }
                    *(u32x4*)(merged + (size_t)row * 1024 + col) = pack8(v0, v1);
                }
            asm volatile("" ::: "memory");
        }
    }
};
struct EpiResid {
    static constexpr bool PERM = false;
    const float* base; float* out;
    __device__ __forceinline__ void operator()(const f32x4 (&acc)[2][2][4][2], const Unit& u, int wr, int wc, int fr, int fq) const {
#pragma unroll
        for (int ai = 0; ai < 2; ++ai) {
            f32x4 bs[4][2][2];
#pragma unroll
            for (int m = 0; m < 4; ++m) {
                const size_t off = (size_t)(u.pm * BM + ai * HALF + wr * 64 + m * 16 + fr) * 1024 + u.pn * BM + wc * 32 + 4 * fq;
#pragma unroll
                for (int bj = 0; bj < 2; ++bj)
#pragma unroll
                    for (int n = 0; n < 2; ++n) bs[m][bj][n] = *(const f32x4*)(base + off + bj * HALF + n * 16);
            }
#pragma unroll
            for (int m = 0; m < 4; ++m) {
                const size_t off = (size_t)(u.pm * BM + ai * HALF + wr * 64 + m * 16 + fr) * 1024 + u.pn * BM + wc * 32 + 4 * fq;
#pragma unroll
                for (int bj = 0; bj < 2; ++bj)
#pragma unroll
                    for (int n = 0; n < 2; ++n) *(f32x4*)(out + off + bj * HALF + n * 16) = bs[m][bj][n] + acc[ai][bj][m][n];
            }
            asm volatile("" ::: "memory");
        }
    }
};
struct EpiRelu2 {
    static constexpr bool PERM = true;
    bf16_t* U;
    __device__ __forceinline__ void operator()(const f32x4 (&acc)[2][2][4][2], const Unit& u, int wr, int wc, int fr, int fq) const {
#pragma unroll
        for (int ai = 0; ai < 2; ++ai)
#pragma unroll
            for (int m = 0; m < 4; ++m) {
                const int row = u.pm * BM + ai * HALF + wr * 64 + m * 16 + fr;
#pragma unroll
                for (int bj = 0; bj < 2; ++bj) {
                    const int col = u.pn * BM + bj * HALF + wc * 32 + 8 * fq;
                    f32x4 v0 = acc[ai][bj][m][0], v1 = acc[ai][bj][m][1];
#pragma unroll
                    for (int j = 0; j < 4; ++j) { const float a = fmaxf(v0[j], 0.f), b = fmaxf(v1[j], 0.f); v0[j] = a * a; v1[j] = b * b; }
                    __builtin_nontemporal_store(pack8(v0, v1), (u32x4*)(U + ((size_t)((row >> 8) * 64 + (col >> 6)) * 256 + (row & 255)) * 64 + (col & 63)));
                }
            }
    }
};
__device__ __forceinline__ float gelu_tanh(float x) { const float y = 0.7978845608028654f * (x + 0.044715f * x * x * x); const float e = __expf(2.0f * y); const float th = 1.0f - 2.0f * __builtin_amdgcn_rcpf(e + 1.0f); return 0.5f * x * (1.0f + th); }
struct EpiHid {
    static constexpr bool PERM = true;
    bf16_t* O; const float* bias;
    __device__ __forceinline__ void operator()(const f32x4 (&acc)[2][2][4][2], const Unit& u, int wr, int wc, int fr, int fq) const {
#pragma unroll
        for (int bj = 0; bj < 2; ++bj) {
            const int col = bj * HALF + wc * 32 + 8 * fq;
            const f32x4 b0 = *(const f32x4*)(bias + col), b1 = *(const f32x4*)(bias + col + 4);
#pragma unroll
            for (int ai = 0; ai < 2; ++ai)
#pragma unroll
                for (int m = 0; m < 4; ++m) {
                    const int row = u.pm * BM + ai * HALF + wr * 64 + m * 16 + fr;
                    f32x4 v0 = acc[ai][bj][m][0] + b0, v1 = acc[ai][bj][m][1] + b1;
#pragma unroll
                    for (int j = 0; j < 4; ++j) { v0[j] = gelu_tanh(v0[j]); v1[j] = gelu_tanh(v1[j]); }
                    *(u32x4*)(O + (size_t)row * 256 + col) = pack8(v0, v1); asm volatile("" ::: "memory");
                }
        }
    }
};
struct EpiPlain {
    static constexpr bool PERM = true;
    bf16_t* O; int ldc;
    __device__ __forceinline__ void operator()(const f32x4 (&acc)[2][2][4][2], const Unit& u, int wr, int wc, int fr, int fq) const {
#pragma unroll
        for (int ai = 0; ai < 2; ++ai)
#pragma unroll
            for (int m = 0; m < 4; ++m) {
                const int row = u.pm * BM + ai * HALF + wr * 64 + m * 16 + fr;
#pragma unroll
                for (int bj = 0; bj < 2; ++bj) { const int col = u.pn * BM + bj * HALF + wc * 32 + 8 * fq; *(u32x4*)(O + (size_t)row * ldc + col) = pack8(acc[ai][bj][m][0], acc[ai][bj][m][1]); }
            }
    }
};
struct Params {
    const float* in[23];
    float* out; unsigned char* ws;
    float inv_freq[8];
};
enum { I_X = 0, I_MEM, I_POS, I_LN_MIX, I_W_IN, I_B_MERGE, I_NQ_NORM, I_NK_NORM, I_CMP_PE, I_CMP_W1, I_CMP_W2, I_GLA_WG, I_GLA_BG, I_GLA_NORM,
       I_MEM_NORM, I_MEM_WKV, I_MEM_QN, I_MEM_KN, I_W_BRANCH, I_W_OUT, I_LN_MLP, I_W_UP, I_W_DOWN };

__device__ __forceinline__ int win_src_col(int n) {
    if (n < 1280) return n;
    if (n < 2816) return n + 24;
    if (n < 3328) return n + 40;
    if (n < 3352) return 1280 + (n - 3328);
    if (n < 3368) return 2840 + (n - 3352);
    if (n < 3584) return -1;
    return n - 216;
}
__device__ __forceinline__ void conv_block(const float* __restrict__ src, int ldsrc, bf16_t* __restrict__ dst, int K  , int n0, int k0, bool winmap, LAS float* tile) {
    const int tid = opq_tid();
    { const int n = tid & 63; const int sc = winmap ? win_src_col(n0 + n) : (n0 + n); const float* sp = src + (size_t)(k0 + (tid >> 6)) * ldsrc + (sc >= 0 ? sc : 0);
      float v[32];
#pragma unroll
      for (int i = 0; i < 32; ++i) v[i] = sp[(size_t)(8 * i) * ldsrc];
      __syncthreads();
#pragma unroll
      for (int i = 0; i < 32; ++i) tile[((tid >> 6) + 8 * i) * 65 + n] = sc >= 0 ? v[i] : 0.f; }
    __syncthreads();
    { const int kp = tid & 127;
#pragma unroll
      for (int i = 0; i < 16; ++i) { const int n2 = (tid >> 7) + 4 * i; const int n = n0 + n2, k = k0 + 2 * kp;
          const size_t di = K > 0 ? (size_t)n * K + k : ((size_t)((n >> 8) * (-K) + (k >> 6)) * 256 + (n & 255)) * 64 + (k & 63);
          *(unsigned*)(dst + di) = pk2(tile[(2 * kp) * 65 + n2], tile[(2 * kp + 1) * 65 + n2]); } }
}
__device__ __forceinline__ void phase_convert(const Params& p, int l, LAS unsigned char* lds, unsigned* ctr, LAS int* slot) {
    asm volatile("" : "+s"(l));
    LAS float* tile = (LAS float*)lds;
    unsigned char* ws = p.ws;
    for (;;) {
        __syncthreads(); if (opq_tid() == 0) *slot = (int)atomicAdd(ctr, 1u); __syncthreads();
        const int it = __builtin_amdgcn_readfirstlane(*slot); if (it >= 1216) break;
        int i = it; const float* src; bf16_t* dst; int K, ld, ntn; bool wm = false; int ldd = 0;
        if (i < 416) { src = p.in[I_W_IN] + (size_t)l * 1024 * DIN; dst = (bf16_t*)(ws + WS_WIN); K = 1024; ld = DIN; ntn = 104; wm = true; }
        else if ((i -= 416) < 96) { const int br = i / 32; i -= br * 32; src = p.in[I_W_BRANCH] + ((size_t)l * 3 + br) * 512 * 1024; dst = (bf16_t*)(ws + WS_WBR) + (size_t)br * 1024 * 512; K = 512; ld = 1024; ntn = 16; }
        else if ((i -= 96) < 64) { src = p.in[I_W_OUT] + (size_t)l * 1024 * 1024; dst = (bf16_t*)(ws + WS_WOUT); K = 1024; ld = 1024; ntn = 16; }
        else if ((i -= 64) < 256) { src = p.in[I_W_UP] + (size_t)l * 1024 * 4096; dst = (bf16_t*)(ws + WS_WUP); K = 1024; ld = 4096; ntn = 64; }
        else if ((i -= 256) < 256) { src = p.in[I_W_DOWN] + (size_t)l * 4096 * 1024; dst = (bf16_t*)(ws + WS_WDN2); K = 4096; ld = 1024; ntn = 16; ldd = -64; }
        else if ((i -= 256) < 64) { src = p.in[I_MEM_WKV] + (size_t)l * 1024 * 1024; dst = (bf16_t*)(ws + WS_WKV); K = 1024; ld = 1024; ntn = 16; }
        else { i -= 64; const int kv = i / 32; i -= kv * 32; src = p.in[I_CMP_W1] + ((size_t)l * 2 + kv) * 2048 * 256; dst = (bf16_t*)(ws + WS_W1) + (size_t)kv * 256 * 2048; K = 2048; ld = 256; ntn = 4; }
        const int tn = i % ntn, kg = i / ntn;
        conv_block(src, ld, dst, ldd ? ldd : K, tn * 64, kg * 256, wm, tile);
    }
    __syncthreads();
}
__device__ __forceinline__ void phase_bias1(const Params& p, int l, LAS unsigned char* lds) {
    asm volatile("" : "+s"(l));
    if (opq_bid() < opq_gdim() - 8) return;
    const int j = opq_bid() - (opq_gdim() - 8), kv = j >> 2, e0 = (j & 3) * 64;
    const int tid = opq_tid(), w = tid >> 6, lane = tid & 63;
    const float* pe = p.in[I_CMP_PE] + ((size_t)l * 2 + kv) * 2048; const float* W1 = p.in[I_CMP_W1] + ((size_t)l * 2 + kv) * 2048 * 256;
    float s = 0.f;
#pragma unroll 1
    for (int f0 = w * 256; f0 < w * 256 + 256; f0 += 16) {
        float pv[16], wv[16];
#pragma unroll
        for (int i = 0; i < 16; ++i) { pv[i] = pe[f0 + i]; wv[i] = W1[(size_t)(f0 + i) * 256 + e0 + lane]; }
#pragma unroll
        for (int i = 0; i < 16; ++i) s += pv[i] * wv[i];
    }
    LAS float* red = (LAS float*)lds;
    __syncthreads(); red[w * 64 + lane] = s; __syncthreads();
    if (w == 0) { float t = 0.f; for (int i = 0; i < 8; ++i) t += red[i * 64 + lane]; ((float*)(p.ws + WS_B1))[kv * 256 + e0 + lane] = t; }
    __syncthreads();
}
__device__ __forceinline__ float wave_sum(float v) {
#pragma unroll
    for (int o = 32; o >= 1; o >>= 1) v += __shfl_xor(v, o);
    return v;
}
__device__ __forceinline__ void phase_rmsnorm(const float* __restrict__ x, const float* __restrict__ g, bf16_t* __restrict__ out, int nrows) {
    const int lane = opq_tid() & 63; const int gw = opq_bid() * 8 + (opq_tid() >> 6), nw = opq_gdim() * 8;
    f32x4 gg[4];
#pragma unroll
    for (int i = 0; i < 4; ++i) gg[i] = ((const f32x4*)g)[lane + 64 * i];
    for (int r0 = gw; r0 < nrows; r0 += 4 * nw) {
        f32x4 v[4][4]; float ss[4];
#pragma unroll
        for (int k = 0; k < 4; ++k) { const int r = r0 + k * nw; const f32x4* xr = (const f32x4*)(x + (size_t)(r < nrows ? r : r0) * 1024);
#pragma unroll
            for (int i = 0; i < 4; ++i) v[k][i] = xr[lane + 64 * i]; }
#pragma unroll
        for (int k = 0; k < 4; ++k) { float s = 0.f;
#pragma unroll
            for (int i = 0; i < 4; ++i) s += v[k][i][0] * v[k][i][0] + v[k][i][1] * v[k][i][1] + v[k][i][2] * v[k][i][2] + v[k][i][3] * v[k][i][3];
            ss[k] = wave_sum(s); }
#pragma unroll
        for (int k = 0; k < 4; ++k) { const int r = r0 + k * nw; if (r < nrows) { const float rs = __builtin_amdgcn_rsqf(ss[k] * (1.0f / 1024.0f) + 1e-6f);
#pragma unroll
            for (int i = 0; i < 4; ++i) { u32x2 w; w.x = pk2(v[k][i][0] * rs * gg[i][0], v[k][i][1] * rs * gg[i][1]); w.y = pk2(v[k][i][2] * rs * gg[i][2], v[k][i][3] * rs * gg[i][3]);
                *(u32x2*)(out + (size_t)r * 1024 + (lane + 64 * i) * 4) = w; } } }
    }
}
__device__ __forceinline__ void phase_softmax_ref(const Params& p, int l) {
    if (opq_bid() != 0 || opq_tid() >= 64) return;
    const int lane = opq_tid();
    float gq = fabsf(p.in[I_NQ_NORM][l * 64 + lane]), gk0 = fabsf(p.in[I_NK_NORM][(l * 3 + 0) * 64 + lane]), gk1 = fabsf(p.in[I_NK_NORM][(l * 3 + 1) * 64 + lane]), gk2 = fabsf(p.in[I_NK_NORM][(l * 3 + 2) * 64 + lane]);
    float gmq = fmaxf(fabsf(p.in[I_MEM_QN][l * 128 + lane]), fabsf(p.in[I_MEM_QN][l * 128 + 64 + lane])), gmk = fmaxf(fabsf(p.in[I_MEM_KN][l * 128 + lane]), fabsf(p.in[I_MEM_KN][l * 128 + 64 + lane]));
#pragma unroll
    for (int o = 32; o >= 1; o >>= 1) { gq = fmaxf(gq, __shfl_xor(gq, o)); gk0 = fmaxf(gk0, __shfl_xor(gk0, o)); gk1 = fmaxf(gk1, __shfl_xor(gk1, o)); gk2 = fmaxf(gk2, __shfl_xor(gk2, o)); gmq = fmaxf(gmq, __shfl_xor(gmq, o)); gmk = fmaxf(gmk, __shfl_xor(gmk, o)); }
    float* CS = (float*)(p.ws + WS_CTL) + 128;
    const float qb = 8.0f * gq * 0.18033688011112042f * 1.001f;
    if (lane == 0) { CS[0] = -fminf(qb * 8.0f * gk0, 100.f); CS[1] = -fminf(qb * 8.0f * gk1, 100.f); CS[2] = -fminf(qb * 8.0f * gk2, 100.f);
        CS[3] = -fminf(11.313708f * gmq * 0.12751743082459868f * 11.313708f * gmk * 1.001f, 100.f); }
}
__device__ __forceinline__ void phase_rope_table(const Params& p) {
    float* tab = (float*)(p.ws + WS_ROPE); const int* pos = (const int*)p.in[I_POS];
    for (int i = opq_bid() * 512 + opq_tid(); i < NT * 8; i += opq_gdim() * 512) {
        const int tok = i >> 3, f = i & 7;
        float ifr = 0.f;
#pragma unroll
        for (int k = 0; k < 8; ++k) if (f == k) ifr = p.inv_freq[k];
        const float angf = (float)pos[tok] * ifr;
        double a = (double)angf; a -= 6.283185307179586 * rint(a * 0.15915494309189535);
        const float r = (float)a; tab[tok * 16 + f] = cosf(r); tab[tok * 16 + 8 + f] = sinf(r);
    }
}
template <bool PAIR, bool ROPE>
__device__ __forceinline__ void norm_vec64(bf16_t* ptr, const float* __restrict__ gain, const float* __restrict__ rt, float scale) {
    u32x4 raw[8]; float x[64];
#pragma unroll
    for (int i = 0; i < 8; ++i) raw[i] = ((const u32x4*)ptr)[i];
    float ss = 0.f;
#pragma unroll
    for (int i = 0; i < 8; ++i) {
        x[i * 8 + 0] = __uint_as_float(raw[i].x << 16); x[i * 8 + 1] = __uint_as_float(raw[i].x & 0xffff0000u);
        x[i * 8 + 2] = __uint_as_float(raw[i].y << 16); x[i * 8 + 3] = __uint_as_float(raw[i].y & 0xffff0000u);
        x[i * 8 + 4] = __uint_as_float(raw[i].z << 16); x[i * 8 + 5] = __uint_as_float(raw[i].z & 0xffff0000u);
        x[i * 8 + 6] = __uint_as_float(raw[i].w << 16); x[i * 8 + 7] = __uint_as_float(raw[i].w & 0xffff0000u);
    }
#pragma unroll
    for (int i = 0; i < 64; ++i) ss += x[i] * x[i];
    if (PAIR) ss += __shfl_xor(ss, 1);
    const float rstd = __builtin_amdgcn_rsqf(ss * (PAIR ? (1.0f / 128.0f) : (1.0f / 64.0f)) + 1e-6f);
#pragma unroll
    for (int i = 0; i < 64; ++i) x[i] = x[i] * rstd * gain[i];
    if (ROPE) {
#pragma unroll
        for (int i = 0; i < 8; ++i) { const float c = rt[i], s = rt[8 + i]; const float a = x[i], b = x[i + 8]; x[i] = a * c - b * s; x[i + 8] = b * c + a * s; }
    }
#pragma unroll
    for (int i = 0; i < 8; ++i) { u32x4 w; w.x = pk2(x[i * 8] * scale, x[i * 8 + 1] * scale); w.y = pk2(x[i * 8 + 2] * scale, x[i * 8 + 3] * scale);
        w.z = pk2(x[i * 8 + 4] * scale, x[i * 8 + 5] * scale); w.w = pk2(x[i * 8 + 6] * scale, x[i * 8 + 7] * scale); ((u32x4*)ptr)[i] = w; }
}
__device__ __forceinline__ void transpose64(const bf16_t* __restrict__ src, bf16_t* __restrict__ dst, LAS bf16_t* T) {
    const int tid = opq_tid(), r = tid >> 3, c8 = (tid & 7) * 8;
    const u32x4 v = *(const u32x4*)(src + r * 64 + c8);
    __syncthreads();
    T[(c8 + 0) * 72 + r] = (bf16_t)(v.x & 0xffff); T[(c8 + 1) * 72 + r] = (bf16_t)(v.x >> 16); T[(c8 + 2) * 72 + r] = (bf16_t)(v.y & 0xffff); T[(c8 + 3) * 72 + r] = (bf16_t)(v.y >> 16);
    T[(c8 + 4) * 72 + r] = (bf16_t)(v.z & 0xffff); T[(c8 + 5) * 72 + r] = (bf16_t)(v.z >> 16); T[(c8 + 6) * 72 + r] = (bf16_t)(v.w & 0xffff); T[(c8 + 7) * 72 + r] = (bf16_t)(v.w >> 16);
    __syncthreads();
    *(u32x4*)(dst + r * 64 + c8) = *(const LAS u32x4*)(T + r * 72 + c8);
}
__device__ __forceinline__ void postproc_item(const Params& p, int l, int item, LAS unsigned char* lds) {
    asm volatile("" : "+s"(l), "+s"(item));
    unsigned char* ws = p.ws; int tid = opq_tid(); asm volatile("" : "+v"(tid));
    const int b = item >> 6, blk = item & 63, tok0 = b * SEQ + blk * 64;
    const float* rope = (const float*)(ws + WS_ROPE);
    {
        const int tk = tid >> 3, h = tid & 7, tok = tok0 + tk;
        norm_vec64<false, true>((bf16_t*)(ws + WS_QN) + (size_t)tok * 512 + h * 64, p.in[I_NQ_NORM] + l * 64, rope + (size_t)tok * 16, 0.18033688011112042f);
    }
    {
        const int tk = tid >> 3, hh = tid & 7, tok = tok0 + tk;
        norm_vec64<true, false>((bf16_t*)(ws + WS_MQ) + (size_t)tok * 512 + hh * 64, p.in[I_MEM_QN] + l * 128 + (hh & 1) * 64, nullptr, 0.12751743082459868f);
    }
    if (tid < 256) {
        const int tk = tid >> 2, g = (tid >> 1) & 1, which = tid & 1, tok = tok0 + tk;
        bf16_t* base = (bf16_t*)(ws + (which ? WS_KW : WS_KS)) + ((size_t)(b * 2 + g) * SEQ + blk * 64 + tk) * 64;
        norm_vec64<false, true>(base, p.in[I_NK_NORM] + (l * 3 + 1 + which) * 64, rope + (size_t)tok * 16, 1.0f);
    }
    LAS bf16_t* T = (LAS bf16_t*)lds;
#pragma unroll 1
    for (int j = 0; j < 4; ++j) { const int g = j & 1, which = j >> 1; const size_t off = ((size_t)(b * 2 + g) * SEQ + blk * 64) * 64;
        transpose64((const bf16_t*)(ws + (which ? WS_VW : WS_VS)) + off, (bf16_t*)(ws + (which ? WS_VTW : WS_VTS)) + off, T); }
    __syncthreads();
}
__device__ __forceinline__ void phase_c2(const Params& p, int l, LAS unsigned char* lds_) {
    asm volatile("" : "+s"(l));
    unsigned char* ws = p.ws; const int lane = opq_tid() & 63; const int gw = opq_bid() * 8 + (opq_tid() >> 6), nw = opq_gdim() * 8;
    const bf16_t* HID = (const bf16_t*)(ws + WS_HID);
    bf16_t* KCMP = (bf16_t*)(ws + WS_KCMP); bf16_t* VCMPT = (bf16_t*)(ws + WS_VCMPT);
    const float* rope = (const float*)(ws + WS_ROPE);
    for (int wi = opq_bid(); wi < 256; wi += opq_gdim()) {
        const int kv = wi >> 7, bg = (wi >> 3) & 15, nb = (wi & 7) * 32;
        LAS float* W2s = (LAS float*)lds_; LAS bf16_t* Hs = (LAS bf16_t*)(lds_ + 65536);
        { const int tid = opq_tid(); const f32x4* W2g = (const f32x4*)(p.in[I_CMP_W2] + ((size_t)l * 2 + kv) * 256 * 64);
          const u32x4* Hg = (const u32x4*)(HID + ((size_t)kv * 4096 + bg * 256 + nb) * 256);
          f32x4 wv[8]; u32x4 hv[2];
#pragma unroll
          for (int i = 0; i < 8; ++i) wv[i] = W2g[tid + 512 * i];
#pragma unroll
          for (int i = 0; i < 2; ++i) hv[i] = Hg[tid + 512 * i];
          __syncthreads();
#pragma unroll
          for (int i = 0; i < 8; ++i) *(LAS f32x4*)(W2s + (tid + 512 * i) * 4) = wv[i];
#pragma unroll
          for (int i = 0; i < 2; ++i) *(LAS u32x4*)(Hs + (tid + 512 * i) * 8) = hv[i]; }
        __syncthreads();
        const int wv_ = opq_tid() >> 6; const int n0 = nb + wv_ * 4;
        const LAS bf16_t* hr = Hs + wv_ * 4 * 256;
        float a0 = 0.f, a1 = 0.f, a2 = 0.f, a3 = 0.f;
#pragma unroll 8
        for (int e = 0; e < 256; ++e) { const float w = W2s[e * 64 + lane]; a0 += bf2f(hr[e]) * w; a1 += bf2f(hr[256 + e]) * w; a2 += bf2f(hr[512 + e]) * w; a3 += bf2f(hr[768 + e]) * w; }
        float av[4] = {a0, a1, a2, a3};
#pragma unroll
        for (int r = 0; r < 4; ++r) {
            const int n = n0 + r; float v = av[r];
            if (kv == 0) {
                if (n < 255) {
                    const float ss = wave_sum(v * v); v = v / sqrtf(ss * (1.0f / 64.0f) + 1e-6f) * p.in[I_NK_NORM][(l * 3 + 0) * 64 + lane];
                    const int tok = (bg >> 1) * SEQ + 16 * n + 31; const float* rt = rope + (size_t)tok * 16;
                    const float oth = __shfl_xor(v, 8);
                    if (lane < 8) v = v * rt[lane] - oth * rt[8 + lane]; else if (lane < 16) v = v * rt[lane - 8] + oth * rt[lane];
                } else v = 0.f;
                KCMP[((size_t)bg * 256 + n) * 64 + lane] = f2bf(v);
            } else {
                if (n >= 255) v = 0.f;
                VCMPT[((size_t)bg * 64 + lane) * 256 + n] = f2bf(v);
            }
        }
    }
    const bf16_t* MKV = (const bf16_t*)(ws + WS_MKV); bf16_t* MK = (bf16_t*)(ws + WS_MK); bf16_t* MVT = (bf16_t*)(ws + WS_MVT);
    for (int it = gw; it < 8192; it += nw) {
        const int row = it >> 2, h = it & 3, b = row >> 8, m = row & 255;
        const unsigned kk = *(const unsigned*)(MKV + (size_t)row * 1024 + h * 128 + lane * 2);
        float k0 = __uint_as_float(kk << 16), k1 = __uint_as_float(kk & 0xffff0000u);
        const float ss = wave_sum(k0 * k0 + k1 * k1); const float rstd = __builtin_amdgcn_rsqf(ss * (1.0f / 128.0f) + 1e-6f);
        const float* gn = p.in[I_MEM_KN] + l * 128 + lane * 2;
        *(unsigned*)(MK + ((size_t)(b * 4 + h) * 256 + m) * 128 + lane * 2) = pk2(k0 * rstd * gn[0], k1 * rstd * gn[1]);
        const unsigned vv = *(const unsigned*)(MKV + (size_t)row * 1024 + 512 + h * 128 + lane * 2);
        bf16_t* vt = MVT + ((size_t)(b * 4 + h) * 128 + lane * 2) * 256 + m;
        vt[0] = (bf16_t)(vv & 0xffff); vt[256] = (bf16_t)(vv >> 16);
    }
}
#define MFMA16(a, b, c) __builtin_amdgcn_mfma_f32_16x16x32_bf16((a), (b), (c), 0, 0, 0)
template <int DH> struct KVRegs { u32x4 k[DH / 64], v[DH / 64]; };
template <int DH>
__device__ __forceinline__ void kv_load(KVRegs<DH>& r, const bf16_t* __restrict__ gK, int ldk, const bf16_t* __restrict__ gVt, int ldv) {
    const int tid = opq_tid();
#pragma unroll
    for (int i = 0; i < DH / 64; ++i) {
        const int idx = tid + i * 512; const int kr = idx / (DH / 8), kc = (idx % (DH / 8)) * 8;
        r.k[i] = *(const u32x4*)(gK + (size_t)kr * ldk + kc);
        const int vr = idx >> 3, vc = (idx & 7) * 8;
        r.v[i] = *(const u32x4*)(gVt + (size_t)vr * ldv + vc);
    }
}
template <int DH>
__device__ __forceinline__ void kv_store(const KVRegs<DH>& r, LAS bf16_t* Kt, LAS bf16_t* Vt) {
    const int tid = opq_tid();
#pragma unroll
    for (int i = 0; i < DH / 64; ++i) {
        const int idx = tid + i * 512; const int kr = idx / (DH / 8), kc = (idx % (DH / 8)) * 8;
        *(LAS u32x4*)(Kt + kr * (DH + 8) + kc) = r.k[i];
        const int vr = idx >> 3, vc = (idx & 7) * 8;
        *(LAS u32x4*)(Vt + vr * 72 + vc) = r.v[i];
    }
}
template <int DH>
__device__ __forceinline__ void qk_scores(const LAS bf16_t* Kt, const bf16x8 (&qf)[2][DH / 32], f32x4 (&st)[4][2], int fr, int fq, float c0) {
#pragma unroll
    for (int kt = 0; kt < 4; ++kt) {
        st[kt][0] = (f32x4){c0, c0, c0, c0}; st[kt][1] = (f32x4){c0, c0, c0, c0};
#pragma unroll
        for (int ks = 0; ks < DH / 32; ++ks) {
            const bf16x8 a = *(const LAS bf16x8*)(Kt + (kt * 16 + fr) * (DH + 8) + ks * 32 + fq * 8);
            st[kt][0] = MFMA16(a, qf[0][ks], st[kt][0]); st[kt][1] = MFMA16(a, qf[1][ks], st[kt][1]);
        }
    }
}
template <int DH> struct FlashState { float m[2], l[2]; f32x4 O[DH / 16][2]; };
template <int DH> __device__ __forceinline__ void flash_init(FlashState<DH>& s) {
    s.m[0] = s.m[1] = 0.f; s.l[0] = s.l[1] = 0.f;
#pragma unroll
    for (int d = 0; d < DH / 16; ++d) { s.O[d][0] = (f32x4){0.f, 0.f, 0.f, 0.f}; s.O[d][1] = (f32x4){0.f, 0.f, 0.f, 0.f}; }
}
template <int DH, bool FAST, bool HASOFF>
__device__ __forceinline__ void flash_step(const LAS bf16_t* Kt, const LAS bf16_t* Vt, const bf16x8 (&qf)[2][DH / 32], const u64 (&mask)[2], const float (&off)[2], FlashState<DH>& s, int fr, int fq, float cneg) {
    f32x4 st[4][2];
    qk_scores<DH>(Kt, qf, st, fr, fq, cneg);
    bf16x8 pb[2][2];
#pragma unroll
    for (int qt = 0; qt < 2; ++qt) {
        float ps = 0.f;
        if (FAST) {
#pragma unroll
            for (int kt = 0; kt < 4; ++kt)
#pragma unroll
                for (int j = 0; j < 4; ++j) { const float v = HASOFF ? st[kt][qt][j] + off[qt] : st[kt][qt][j]; const float pv = __builtin_amdgcn_exp2f(v); st[kt][qt][j] = pv; ps += pv; }
            s.l[qt] += ps;
        } else {
            const u64 msh = mask[qt] >> (fq * 4);
#pragma unroll
            for (int kt = 0; kt < 4; ++kt)
#pragma unroll
                for (int j = 0; j < 4; ++j) { const bool ok = (msh >> (kt * 16 + j)) & 1ull; const float pv = ok ? __builtin_amdgcn_exp2f(st[kt][qt][j]) : 0.f; st[kt][qt][j] = pv; ps += pv; }
            s.l[qt] += ps;
        }
#pragma unroll
        for (int kb = 0; kb < 2; ++kb) {
            u32x4 tw; tw.x = pk2(st[2 * kb][qt][0], st[2 * kb][qt][1]); tw.y = pk2(st[2 * kb][qt][2], st[2 * kb][qt][3]); tw.z = pk2(st[2 * kb + 1][qt][0], st[2 * kb + 1][qt][1]); tw.w = pk2(st[2 * kb + 1][qt][2], st[2 * kb + 1][qt][3]);
            const bf16x8 t = __builtin_bit_cast(bf16x8, tw);
            pb[kb][qt] = t;
        }
    }
#pragma unroll
    for (int d = 0; d < DH / 16; ++d)
#pragma unroll
        for (int kb = 0; kb < 2; ++kb) {
            const bf16x4 lo = *(const LAS bf16x4*)(Vt + (d * 16 + fr) * 72 + kb * 32 + fq * 4);
            const bf16x4 hi = *(const LAS bf16x4*)(Vt + (d * 16 + fr) * 72 + kb * 32 + 16 + fq * 4);
            const bf16x8 a = __builtin_shufflevector(lo, hi, 0, 1, 2, 3, 4, 5, 6, 7);
            s.O[d][0] = MFMA16(a, pb[kb][0], s.O[d][0]); s.O[d][1] = MFMA16(a, pb[kb][1], s.O[d][1]);
        }
}
__device__ __forceinline__ u64 low_mask(int n) { return n >= 63 ? ~0ull : (n < 0 ? 0ull : ((2ull << n) - 1ull)); }

template <int MODE  >
__device__ __forceinline__ void nsa_run(LAS unsigned char* lds, u64 blocks, const bf16_t* Kb, size_t kstr, int ldk, const bf16_t* Vb, size_t vstr, int ldv,
                                        const bf16x8 (&qf)[2][2], FlashState<64>& fs, int qi, const int (&tq)[2], const int (&qidx)[2], int fr, int fq, float cneg) {
    const LAS u64* sel = (const LAS u64*)(lds + 140288);
    if (blocks == 0ull) return;
    KVRegs<64> ra, rb;
    int j0 = __builtin_ctzll(blocks); blocks &= blocks - 1;
    kv_load<64>(ra, Kb + (size_t)j0 * kstr, ldk, Vb + (size_t)j0 * vstr, ldv);
    int j1 = -1;
    if (blocks != 0ull) { j1 = __builtin_ctzll(blocks); blocks &= blocks - 1; kv_load<64>(rb, Kb + (size_t)j1 * kstr, ldk, Vb + (size_t)j1 * vstr, ldv); }
    int par = 0;
    __syncthreads();
#define NSA_BLOCK(KT, VT, JC) do { \
        const int jc = (JC); u64 mask[2]; float off[2] = {0.f, 0.f}; \
        const bool fast = MODE == 0 ? (qi >= 1 && 64 * jc + 63 <= 4 * qi - 2) : (MODE == 1 ? jc != qi : (jc != qi && jc != qi - 8)); \
        if (fast) { \
            mask[0] = mask[1] = ~0ull; \
            if (MODE == 1) { off[0] = ((sel[qidx[0]] >> jc) & 1ull) ? 0.f : -1e30f; off[1] = ((sel[qidx[1]] >> jc) & 1ull) ? 0.f : -1e30f; } \
            flash_step<64, true, MODE == 1>(KT, VT, qf, mask, off, fs, fr, fq, cneg); \
        } else { \
            _Pragma("unroll") for (int qt = 0; qt < 2; ++qt) { \
                if (MODE == 0) { const int t = qi * 64 + tq[qt]; const int nlim = t >= 31 ? ((t - 31) >> 4) : -1; mask[qt] = low_mask(nlim - 64 * jc); } \
                else if (MODE == 1) { const u64 sm = sel[qidx[qt]]; mask[qt] = ((sm >> jc) & 1ull) ? (jc == qi ? low_mask(tq[qt]) : ~0ull) : 0ull; } \
                else { mask[qt] = jc == qi ? low_mask(tq[qt]) : (jc == qi - 8 ? ~low_mask(tq[qt]) : ~0ull); } \
            } \
            flash_step<64, false, false>(KT, VT, qf, mask, off, fs, fr, fq, cneg); \
        } } while (0)
    for (;;) {
        LAS bf16_t* Ka = (LAS bf16_t*)(lds + (par * 2) * 9216); LAS bf16_t* Kb2 = (LAS bf16_t*)(lds + (par * 2 + 1) * 9216);
        LAS bf16_t* Va = (LAS bf16_t*)(lds + 36864 + (par * 2) * 9216); LAS bf16_t* Vb2 = (LAS bf16_t*)(lds + 36864 + (par * 2 + 1) * 9216);
        const int ja = j0, jb = j1;
        kv_store<64>(ra, Ka, Va);
        if (jb >= 0) kv_store<64>(rb, Kb2, Vb2);
        __syncthreads();
        j0 = -1; j1 = -1;
        if (blocks != 0ull) { j0 = __builtin_ctzll(blocks); blocks &= blocks - 1; kv_load<64>(ra, Kb + (size_t)j0 * kstr, ldk, Vb + (size_t)j0 * vstr, ldv); }
        if (blocks != 0ull) { j1 = __builtin_ctzll(blocks); blocks &= blocks - 1; kv_load<64>(rb, Kb + (size_t)j1 * kstr, ldk, Vb + (size_t)j1 * vstr, ldv); }
        NSA_BLOCK(Ka, Va, ja);
        if (jb >= 0) NSA_BLOCK(Kb2, Vb2, jb);
        par ^= 1;
        if (j0 < 0) break;
    }
#undef NSA_BLOCK
}
__device__ __forceinline__ void nsa_item(const Params& p, int l, int item, LAS unsigned char* lds) {
    asm volatile("" : "+s"(l), "+s"(item));
    unsigned char* ws = p.ws;
    const int qi = 63 - (item >> 4), bg = item & 15, b = bg >> 1, g = bg & 1;
    int tid = opq_tid(); asm volatile("" : "+v"(tid));
    const int w = tid >> 6, lane = tid & 63, fr = lane & 15, fq = lane >> 4;
    const int r = w >> 1, h = g * 4 + r;
    int tq[2], qidx[2]; tq[0] = (w & 1) * 32 + fr; tq[1] = tq[0] + 16; qidx[0] = tq[0]; qidx[1] = tq[1];
    const int tok0 = b * SEQ + qi * 64;
    bf16_t* QN = (bf16_t*)(ws + WS_QN);
    bf16x8 qf[2][2];
#pragma unroll
    for (int qt = 0; qt < 2; ++qt)
#pragma unroll
        for (int ks = 0; ks < 2; ++ks) qf[qt][ks] = *(const bf16x8*)(QN + (size_t)(tok0 + tq[qt]) * 512 + h * 64 + ks * 32 + fq * 8);
    float cneg[3];
#pragma unroll
    for (int k = 0; k < 3; ++k) cneg[k] = ((const float*)(ws + WS_CTL))[128 + k];
    LAS float* imp = (LAS float*)(lds + 73728); LAS u64* sel = (LAS u64*)(lds + 140288);
    LAS float* finl = (LAS float*)(lds + 73728);
    FlashState<64> fs;
#define NSA_LTOT() do { _Pragma("unroll") for (int qt = 0; qt < 2; ++qt) { float lt = fs.l[qt]; lt += __shfl_xor(lt, 16); lt += __shfl_xor(lt, 32); fs.l[qt] = lt; } } while (0)
#define NSA_SC(k, qt) ({ const float gk_ = sigmoidf_(((const float*)(ws + WS_SM))[(size_t)(tok0 + tq[qt]) * 40 + h * 3 + (k)]); fs.l[qt] > 0.f ? gk_ / fs.l[qt] : 0.f; })
    const int ncb = ((4 * qi + 2) >> 6) + 1;
    const bf16_t* KC = (const bf16_t*)(ws + WS_KCMP) + (size_t)bg * 256 * 64; const bf16_t* VC = (const bf16_t*)(ws + WS_VCMPT) + (size_t)bg * 64 * 256;
    flash_init<64>(fs);
    nsa_run<0>(lds, (1ull << ncb) - 1ull, KC, 4096, 64, VC, 64, 256, qf, fs, qi, tq, qidx, fr, fq, cneg[0]);
    NSA_LTOT();
    if (qi >= 15) {
        LAS bf16_t* Kt0 = (LAS bf16_t*)lds;
        float inv[2]; inv[0] = fs.l[0] > 0.f ? 1.0f / fs.l[0] : 0.f; inv[1] = fs.l[1] > 0.f ? 1.0f / fs.l[1] : 0.f;
        float carry[2] = {0.f, 0.f};
        u32x4 kpre[4];
#pragma unroll
        for (int cb = 0; cb < 4; ++cb) if (cb < ncb) kpre[cb] = *(const u32x4*)(KC + (size_t)cb * 4096 + (tid >> 3) * 64 + (tid & 7) * 8);
#pragma unroll
        for (int cb = 0; cb < 4; ++cb) {
            if (cb >= ncb) break;
            { const int kr = tid >> 3, kc = (tid & 7) * 8; __syncthreads(); *(LAS u32x4*)(Kt0 + kr * 72 + kc) = kpre[cb]; __syncthreads(); }
            f32x4 st[4][2]; qk_scores<64>(Kt0, qf, st, fr, fq, cneg[0]);
#pragma unroll
            for (int qt = 0; qt < 2; ++qt) {
                const int t = qi * 64 + tq[qt]; const int nlim = (t - 31) >> 4;
#pragma unroll
                for (int kt = 0; kt < 4; ++kt) {
                    const int n0 = cb * 64 + kt * 16 + fq * 4; float pj[4];
#pragma unroll
                    for (int j = 0; j < 4; ++j) pj[j] = (n0 + j <= nlim) ? __builtin_amdgcn_exp2f(st[kt][qt][j] - fs.m[qt]) * inv[qt] : 0.f;
                    const float gs = (pj[0] + pj[1]) + (pj[2] + pj[3]);
                    const float up = __shfl(pj[3], (lane + 48) & 63);
                    const float prev = fq > 0 ? up : carry[qt];
                    if (fq == 0) carry[qt] = up;
                    imp[(r * 64 + qidx[qt]) * 65 + (n0 >> 2)] = gs + prev;
                }
            }
        }
        __syncthreads();
        for (int i = tid; i < 64 * 64; i += 512) { const int q = i >> 6, j = i & 63; if (j <= qi) imp[q * 65 + j] = (imp[q * 65 + j] + imp[(64 + q) * 65 + j]) + (imp[(128 + q) * 65 + j] + imp[(192 + q) * 65 + j]); }
        __syncthreads();
        {
            const int q = tid >> 3, sub = tid & 7; unsigned byte = 0u;
            float row[64];
#pragma unroll
            for (int k = 0; k < 64; ++k) { const float v = imp[q * 65 + k]; row[k] = k > qi ? -1e30f : ((k == 0 || k >= qi - 1) ? 1e4f : v); }
#pragma unroll 1
            for (int jj = 0; jj < 8; ++jj) {
                const int j = sub * 8 + jj; if (j > qi) break;
                const float sj = (j == 0 || j >= qi - 1) ? 1e4f : imp[q * 65 + j]; int rank = 0;
#pragma unroll
                for (int k = 0; k < 64; ++k) rank += (row[k] > sj || (row[k] == sj && k < j)) ? 1 : 0;
                if (rank < 16) byte |= 1u << jj;
            }
            ((LAS unsigned char*)sel)[q * 8 + sub] = (unsigned char)byte;
        }
    } else {
        if (tid < 64) sel[tid] = low_mask(qi);
    }
    __syncthreads();
    u64 uni;
    { u64 v = sel[lane]; unsigned lo = (unsigned)v, hi = (unsigned)(v >> 32);
#pragma unroll
      for (int o = 32; o >= 1; o >>= 1) { lo |= __shfl_xor(lo, o); hi |= __shfl_xor(hi, o); }
      uni = ((u64)(unsigned)__builtin_amdgcn_readfirstlane(hi) << 32) | (unsigned)__builtin_amdgcn_readfirstlane(lo); }
#pragma unroll
    for (int qt = 0; qt < 2; ++qt) { const float sc = NSA_SC(0, qt);
#pragma unroll
        for (int d = 0; d < 4; ++d)
#pragma unroll
            for (int r2 = 0; r2 < 4; ++r2) finl[((qt * 4 + d) * 4 + r2) * 512 + tid] = fs.O[d][qt][r2] * sc; }
    flash_init<64>(fs);
    nsa_run<1>(lds, uni & low_mask(qi), (const bf16_t*)(ws + WS_KS) + (size_t)bg * SEQ * 64, 4096, 64, (const bf16_t*)(ws + WS_VTS) + (size_t)bg * SEQ * 64, 4096, 64, qf, fs, qi, tq, qidx, fr, fq, cneg[1]);
    NSA_LTOT();
#pragma unroll
    for (int qt = 0; qt < 2; ++qt) { const float sc = NSA_SC(1, qt);
#pragma unroll
        for (int d = 0; d < 4; ++d)
#pragma unroll
            for (int r2 = 0; r2 < 4; ++r2) finl[((qt * 4 + d) * 4 + r2) * 512 + tid] += fs.O[d][qt][r2] * sc; }
    flash_init<64>(fs);
    { const int j0 = qi >= 8 ? qi - 8 : 0; const u64 wb = low_mask(qi) & ~(j0 > 0 ? low_mask(j0 - 1) : 0ull);
      nsa_run<2>(lds, wb, (const bf16_t*)(ws + WS_KW) + (size_t)bg * SEQ * 64, 4096, 64, (const bf16_t*)(ws + WS_VTW) + (size_t)bg * SEQ * 64, 4096, 64, qf, fs, qi, tq, qidx, fr, fq, cneg[2]); }
    NSA_LTOT();
#pragma unroll
    for (int qt = 0; qt < 2; ++qt) { const float sc = NSA_SC(2, qt);
#pragma unroll
        for (int d = 0; d < 4; ++d) { float v[4];
#pragma unroll
            for (int r2 = 0; r2 < 4; ++r2) v[r2] = finl[((qt * 4 + d) * 4 + r2) * 512 + tid] + fs.O[d][qt][r2] * sc;
            u32x2 o; o.x = pk2(v[0], v[1]); o.y = pk2(v[2], v[3]);
            *(u32x2*)(QN + (size_t)(tok0 + tq[qt]) * 512 + h * 64 + d * 16 + fq * 4) = o; } }
#undef NSA_LTOT
#undef NSA_SC
    __syncthreads();
}
__device__ __forceinline__ void mem_item(const Params& p, int item, LAS unsigned char* lds) {
    asm volatile("" : "+s"(item));
    unsigned char* ws = p.ws;
    const int qb = item & 15, bh = item >> 4, b = bh >> 2, h = bh & 3;
    int tid = opq_tid(); asm volatile("" : "+v"(tid));
    const int w = tid >> 6, lane = tid & 63, fr = lane & 15, fq = lane >> 4;
    bf16_t* MQ = (bf16_t*)(ws + WS_MQ);
    const int tokb = b * SEQ + qb * 256 + w * 32;
    bf16x8 qf[2][4];
#pragma unroll
    for (int qt = 0; qt < 2; ++qt)
#pragma unroll
        for (int ks = 0; ks < 4; ++ks) qf[qt][ks] = *(const bf16x8*)(MQ + (size_t)(tokb + qt * 16 + fr) * 512 + h * 128 + ks * 32 + fq * 8);
    const bf16_t* Kb = (const bf16_t*)(ws + WS_MK) + (size_t)bh * 256 * 128; const bf16_t* Vb = (const bf16_t*)(ws + WS_MVT) + (size_t)bh * 128 * 256;
    LAS bf16_t* Kt[2] = {(LAS bf16_t*)lds, (LAS bf16_t*)(lds + 17408)}; LAS bf16_t* Vt[2] = {(LAS bf16_t*)(lds + 34816), (LAS bf16_t*)(lds + 53248)};
    const float cmem = ((const float*)(ws + WS_CTL))[128 + 3];
    FlashState<128> fs; flash_init<128>(fs);
    KVRegs<128> r; kv_load<128>(r, Kb, 128, Vb, 256);
    u64 mask[2] = {~0ull, ~0ull}; const float off0[2] = {0.f, 0.f};
    __syncthreads();
#pragma unroll 1
    for (int j = 0; j < 4; ++j) {
        kv_store<128>(r, Kt[j & 1], Vt[j & 1]);
        __syncthreads();
        if (j < 3) kv_load<128>(r, Kb + (size_t)(j + 1) * 64 * 128, 128, Vb + (j + 1) * 64, 256);
        flash_step<128, true, false>(Kt[j & 1], Vt[j & 1], qf, mask, off0, fs, fr, fq, cmem);
    }
#pragma unroll
    for (int qt = 0; qt < 2; ++qt) {
        float lt = fs.l[qt]; lt += __shfl_xor(lt, 16); lt += __shfl_xor(lt, 32); const float sc = 1.0f / lt;
#pragma unroll
        for (int d = 0; d < 8; ++d) { const f32x4 o = fs.O[d][qt] * sc; u32x2 v; v.x = pk2(o[0], o[1]); v.y = pk2(o[2], o[3]);
            *(u32x2*)(MQ + (size_t)(tokb + qt * 16 + fr) * 512 + h * 128 + d * 16 + fq * 4) = v; }
    }
    __syncthreads();
}
template <int STAGE>
__device__ __forceinline__ void gla_chunk_item(const Params& p, int l, int item, LAS unsigned char* lds) {
    asm volatile("" : "+s"(l), "+s"(item));
    unsigned char* ws = p.ws;
    const int bh = item >> 6, b = bh >> 2, h = bh & 3, c = item & 63, t0 = c * 64;
    int tid = opq_tid();
    const int w = __builtin_amdgcn_readfirstlane(tid >> 6), lane = tid & 63, fr = lane & 15, fq = lane >> 4;
    LAS bf16_t* Qt = (LAS bf16_t*)lds; LAS bf16_t* Kt = (LAS bf16_t*)(lds + 9216); LAS bf16_t* Kht = (LAS bf16_t*)(lds + 18432); LAS bf16_t* At = (LAS bf16_t*)(lds + 27648);
    LAS bf16_t* Vt = (LAS bf16_t*)(lds + 36864); LAS bf16_t* St = (LAS bf16_t*)(lds + 55296); LAS float* segsum = (LAS float*)(lds + 73728);
    const int d = lane, seg = w;
    const float* SM = (const float*)(ws + WS_SM);
    const bf16_t* GQ = (const bf16_t*)(ws + WS_GQ) + (size_t)bh * SEQ * 64; const bf16_t* GK = (const bf16_t*)(ws + WS_GK) + (size_t)bh * SEQ * 64;
    const bf16_t* GV = (const bf16_t*)(ws + WS_GV) + (size_t)bh * SEQ * 128; bf16_t* GR = (bf16_t*)(ws + WS_GR);
    bf16_t* GS = (bf16_t*)(ws + WS_GS) + (size_t)item * 8192; float* EB = (float*)(ws + WS_EB) + (size_t)item * 64;
    float wg[16];
#pragma unroll
    for (int r = 0; r < 16; ++r) wg[r] = p.in[I_GLA_WG][((size_t)l * 16 + r) * 256 + h * 64 + d];
    const float bgv = p.in[I_GLA_BG][l * 256 + h * 64 + d];
    f32x4 gl4[8][4];
#pragma unroll
    for (int ii = 0; ii < 8; ++ii) { const float* gl = SM + (size_t)(b * SEQ + t0 + seg * 8 + ii) * 40 + 24;
#pragma unroll
        for (int r4 = 0; r4 < 4; ++r4) gl4[ii][r4] = *(const f32x4*)(gl + r4 * 4); }
    float qv[8], kv[8];
#pragma unroll
    for (int ii = 0; ii < 8; ++ii) { const size_t o = (size_t)(t0 + seg * 8 + ii) * 64 + d; if (STAGE == 3) qv[ii] = bf2f(GQ[o]); kv[ii] = bf2f(GK[o]); }
    u32x4 vraw[2], sraw[2];
#pragma unroll
    for (int pc = 0; pc < 2; ++pc) { const int idx = tid + pc * 512; vraw[pc] = *(const u32x4*)(GV + (size_t)(t0 + (tid & 63)) * 128 + ((tid >> 6) + 8 * pc) * 8);
        if (STAGE == 3) sraw[pc] = *(const u32x4*)(GS + (idx >> 3) * 64 + (idx & 7) * 8); }
    u32x2 rgraw[4];
    if (STAGE == 3) {
        const bf16_t* gp = GR + (size_t)(b * SEQ + t0 + (w & 3) * 16 + fr) * 512 + h * 128 + (w >> 2) * 64 + fq * 4;
#pragma unroll
        for (int vv = 0; vv < 4; ++vv) rgraw[vv] = *(const u32x2*)(gp + vv * 16);
    }
    float cs[8]; float run = 0.f;
#pragma unroll
    for (int ii = 0; ii < 8; ++ii) {
        float x = bgv;
#pragma unroll
        for (int r4 = 0; r4 < 4; ++r4) { const f32x4 gvv = gl4[ii][r4]; x += gvv[0] * wg[r4 * 4] + gvv[1] * wg[r4 * 4 + 1] + gvv[2] * wg[r4 * 4 + 2] + gvv[3] * wg[r4 * 4 + 3]; }
        const float ls = fminf(x, 0.f) - __logf(1.0f + __expf(-fabsf(x)));
        run += ls * (1.0f / 16.0f); cs[ii] = run;
    }
    segsum[seg * 64 + d] = run;
    __syncthreads();
    float pre = 0.f, tot = 0.f;
#pragma unroll
    for (int s2 = 0; s2 < 8; ++s2) { const float v = segsum[s2 * 64 + d]; tot += v; if (s2 < seg) pre += v; }
#pragma unroll
    for (int ii = 0; ii < 8; ++ii) {
        const int i = seg * 8 + ii; const float bi = pre + cs[ii];
        if (STAGE == 3) { Qt[i * 72 + d] = f2bf(qv[ii] * __expf(bi) * 0.125f); Kt[i * 72 + d] = f2bf(kv[ii] * __expf(-bi)); }
        else Kht[d * 72 + i] = f2bf(kv[ii] * __expf(tot - bi));
    }
    if (STAGE == 1 && seg == 0) EB[d] = __expf(tot);
#pragma unroll
    for (int pc = 0; pc < 2; ++pc) { const int idx = tid + pc * 512; const int i = tid & 63, v0 = ((tid >> 6) + 8 * pc) * 8; const u32x4 v = vraw[pc];
        Vt[(v0 + 0) * 72 + i] = (bf16_t)(v.x & 0xffff); Vt[(v0 + 1) * 72 + i] = (bf16_t)(v.x >> 16); Vt[(v0 + 2) * 72 + i] = (bf16_t)(v.y & 0xffff); Vt[(v0 + 3) * 72 + i] = (bf16_t)(v.y >> 16);
        Vt[(v0 + 4) * 72 + i] = (bf16_t)(v.z & 0xffff); Vt[(v0 + 5) * 72 + i] = (bf16_t)(v.z >> 16); Vt[(v0 + 6) * 72 + i] = (bf16_t)(v.w & 0xffff); Vt[(v0 + 7) * 72 + i] = (bf16_t)(v.w >> 16);
        if (STAGE == 3) *(LAS u32x4*)(St + (idx >> 3) * 72 + (idx & 7) * 8) = sraw[pc]; }
    __syncthreads();
    if (STAGE == 1) {
#pragma unroll
        for (int dt = 0; dt < 4; ++dt) {
            f32x4 acc = (f32x4){0.f, 0.f, 0.f, 0.f};
#pragma unroll
            for (int ks = 0; ks < 2; ++ks) { const bf16x8 a = *(const LAS bf16x8*)(Kht + (dt * 16 + fr) * 72 + ks * 32 + fq * 8); const bf16x8 bb = *(const LAS bf16x8*)(Vt + (w * 16 + fr) * 72 + ks * 32 + fq * 8); acc = MFMA16(a, bb, acc); }
            u32x2 o; o.x = pk2(acc[0], acc[1]); o.y = pk2(acc[2], acc[3]);
            *(u32x2*)(GS + (w * 16 + fr) * 64 + dt * 16 + fq * 4) = o;
        }
    } else {
        const int it = w & 3, vh = w >> 2;
        LAS bf16_t* Aw = vh ? (LAS bf16_t*)(lds + 75776) : At;
#pragma unroll
        for (int jt = 0; jt < 4; ++jt) {
            f32x4 a4 = (f32x4){0.f, 0.f, 0.f, 0.f};
            if (jt <= it) {
#pragma unroll
                for (int ks = 0; ks < 2; ++ks) { const bf16x8 a = *(const LAS bf16x8*)(Qt + (it * 16 + fr) * 72 + ks * 32 + fq * 8); const bf16x8 bb = *(const LAS bf16x8*)(Kt + (jt * 16 + fr) * 72 + ks * 32 + fq * 8); a4 = MFMA16(a, bb, a4); }
                if (jt == it) {
#pragma unroll
                    for (int r = 0; r < 4; ++r) if (fr > fq * 4 + r) a4[r] = 0.f;
                }
            }
#pragma unroll
            for (int r = 0; r < 4; ++r) Aw[(it * 16 + fq * 4 + r) * 72 + jt * 16 + fr] = f2bf(a4[r]);
        }
        f32x4 o[4];
#pragma unroll
        for (int vv = 0; vv < 4; ++vv) {
            const int vt = vh * 4 + vv;
            f32x4 acc = (f32x4){0.f, 0.f, 0.f, 0.f};
#pragma unroll
            for (int ks = 0; ks < 2; ++ks) { const bf16x8 a = *(const LAS bf16x8*)(Aw + (it * 16 + fr) * 72 + ks * 32 + fq * 8); const bf16x8 bb = *(const LAS bf16x8*)(Vt + (vt * 16 + fr) * 72 + ks * 32 + fq * 8); acc = MFMA16(bb, a, acc); }
#pragma unroll
            for (int ks = 0; ks < 2; ++ks) { const bf16x8 a = *(const LAS bf16x8*)(Qt + (it * 16 + fr) * 72 + ks * 32 + fq * 8); const bf16x8 bb = *(const LAS bf16x8*)(St + (vt * 16 + fr) * 72 + ks * 32 + fq * 8); acc = MFMA16(bb, a, acc); }
            o[vv] = acc;
        }
        float ss = 0.f;
#pragma unroll
        for (int vv = 0; vv < 4; ++vv) ss += (o[vv][0] * o[vv][0] + o[vv][1] * o[vv][1]) + (o[vv][2] * o[vv][2] + o[vv][3] * o[vv][3]);
        ss += __shfl_xor(ss, 16); ss += __shfl_xor(ss, 32);
        if (fq == 0) segsum[vh * 64 + it * 16 + fr] = ss;
        __syncthreads();
        ss = segsum[it * 16 + fr] + segsum[64 + it * 16 + fr];
        const float rstd = __builtin_amdgcn_rsqf(ss * (1.0f / 128.0f) + 1e-6f);
        bf16_t* gp = GR + (size_t)(b * SEQ + t0 + it * 16 + fr) * 512 + h * 128 + vh * 64 + fq * 4;
        const float* gnp = p.in[I_GLA_NORM] + l * 128 + vh * 64 + fq * 4;
#pragma unroll
        for (int vv = 0; vv < 4; ++vv) {
            const f32x4 gn4 = *(const f32x4*)(gnp + vv * 16); const u32x2 rr = rgraw[vv];
            const float g0 = __uint_as_float(rr.x << 16), g1 = __uint_as_float(rr.x & 0xffff0000u), g2 = __uint_as_float(rr.y << 16), g3 = __uint_as_float(rr.y & 0xffff0000u);
            u32x2 ov; ov.x = pk2(o[vv][0] * rstd * gn4[0] * g0 * sigmoidf_(g0), o[vv][1] * rstd * gn4[1] * g1 * sigmoidf_(g1));
            ov.y = pk2(o[vv][2] * rstd * gn4[2] * g2 * sigmoidf_(g2), o[vv][3] * rstd * gn4[3] * g3 * sigmoidf_(g3));
            *(u32x2*)(gp + vv * 16) = ov;
        }
    }
}
__device__ __forceinline__ void gla_scan(const Params& p) {
    unsigned char* ws = p.ws; bf16_t* GS = (bf16_t*)(ws + WS_GS); const float* EB = (const float*)(ws + WS_EB);
    for (int g = opq_bid() * 512 + opq_tid(); g < 32 * 4096; g += opq_gdim() * 512) {
        const int bh = g >> 12, e = (g & 4095) * 2, dd = e & 63;
        float s0 = 0.f, s1 = 0.f;
#pragma unroll 1
        for (int c0 = 0; c0 < 64; c0 += 8) {
            unsigned u[8]; float e0[8], e1[8];
#pragma unroll
            for (int k = 0; k < 8; ++k) { const size_t ch = (size_t)bh * 64 + c0 + k; u[k] = *(const unsigned*)(GS + ch * 8192 + e); const float2 ev = *(const float2*)(EB + ch * 64 + dd); e0[k] = ev.x; e1[k] = ev.y; }
#pragma unroll
            for (int k = 0; k < 8; ++k) { const size_t ch = (size_t)bh * 64 + c0 + k; *(unsigned*)(GS + ch * 8192 + e) = pk2(s0, s1);
                s0 = e0[k] * s0 + __uint_as_float(u[k] << 16); s1 = e1[k] * s1 + __uint_as_float(u[k] & 0xffff0000u); }
        }
    }
}
__device__ __forceinline__ int fetch_item(unsigned* ctr, LAS int* slot) {
    __syncthreads(); if (opq_tid() == 0) *slot = (int)atomicAdd(ctr, 1u); __syncthreads(); return __builtin_amdgcn_readfirstlane(*slot);
}
#define AS4 __attribute__((address_space(4)))
__device__ __forceinline__ void grid_barrier(unsigned* bar, unsigned& epoch) {
    asm volatile("s_waitcnt vmcnt(0) lgkmcnt(0)" ::: "memory");
    __syncthreads();
    epoch += (unsigned)opq_gdim();
    if (opq_tid() == 0) {
        __builtin_amdgcn_fence(__ATOMIC_RELEASE, "agent");
        __hip_atomic_fetch_add(bar, 1u, __ATOMIC_RELAXED, __HIP_MEMORY_SCOPE_AGENT);
        while (__hip_atomic_load(bar, __ATOMIC_RELAXED, __HIP_MEMORY_SCOPE_AGENT) < epoch) __builtin_amdgcn_s_sleep(1);
        __builtin_amdgcn_fence(__ATOMIC_ACQUIRE, "agent");
    }
    __syncthreads();
}
#define GRID_SYNC() grid_barrier((unsigned*)(kws_ + WS_CTL) + 64, epoch_)
#if defined(__HIP_DEVICE_COMPILE__)
#define PLOAD_ const Params p = *kp_;
#else
#define PLOAD_ const Params p = p_arg;
#endif
#define PH_BEGIN \
    const AS4 Params* kp_ = (const AS4 Params*)__builtin_amdgcn_kernarg_segment_ptr(); asm volatile("" : "+s"(kp_)); \
    PLOAD_ unsigned char* ws = p.ws; unsigned* ctl = (unsigned*)(ws + WS_CTL); (void)ctl; \
    int l = l_; asm volatile("" : "+s"(l)); \
    const int G = opq_gdim(), c = opq_bid(); (void)G; (void)c; \
    bf16_t* H = (bf16_t*)(ws + WS_H); bf16_t* HM = (bf16_t*)(ws + WS_HM); unsigned char* Gb = ws + WS_G; bf16_t* MG = (bf16_t*)(ws + WS_MERGED); bf16_t* U = (bf16_t*)(ws + WS_U); \
    const bf16_t* WIN = (const bf16_t*)(ws + WS_WIN); const float* xin = l == 0 ? p.in[I_X] : p.out; \
    (void)H; (void)HM; (void)Gb; (void)MG; (void)U; (void)WIN; (void)xin;
__global__ void __launch_bounds__(512, 2) fwd_kernel(Params p_arg) {
    extern __shared__ __attribute__((aligned(16))) unsigned char lds_raw[];
    LAS unsigned char* lds = (LAS unsigned char*)lds_raw;
    LAS int* slot = (LAS int*)(lds + LDS_BYTES - 16);
    cg::grid_group grid = cg::this_grid();
    unsigned char* kws_ = p_arg.ws; unsigned epoch_ = 0u;
#if defined(PRX)
    unsigned long long tacc0_ = 0ull, tacc1_ = 0ull, tprev_ = __builtin_amdgcn_s_memrealtime();
#define PROBE_MARK(id) do { const unsigned long long now_ = __builtin_amdgcn_s_memrealtime(); if ((id) == PRX) tacc0_ += now_ - tprev_; if ((id) == PRY) tacc1_ += now_ - tprev_; tprev_ = now_; } while (0)
#else
#define PROBE_MARK(id) do { } while (0)
#endif
    grid.sync();
#pragma unroll 1
    for (int l_ = 0; l_ < DEPTH; ++l_) {
#if !defined(ONLY) || ONLY == 0
        { PH_BEGIN
        if (l == 0) phase_rope_table(p);
        phase_bias1(p, l, lds);
        phase_convert(p, l, lds, ctl + l * 8 + 5, slot);
        phase_softmax_ref(p, l);
        phase_rmsnorm(xin, p.in[I_LN_MIX] + l * 1024, H, NT);
        phase_rmsnorm(p.in[I_MEM], p.in[I_MEM_NORM] + l * 1024, HM, 2048); }
        GRID_SYNC(); PROBE_MARK(0);
#endif
#if !defined(ONLY) || ONLY == 1
        { PH_BEGIN
        { StaticOrder S; S.init(NT, 3584, G, c); EpiInProj E{ws}; gemm_phase(lds, Gemm{H, WIN, NT, 3584, 1024, 1024, 1024, 0, 0}, S, E); }
        { StaticOrder S; S.init(NT, 3072, G, c); EpiGates E{Gb, p.in[I_B_MERGE] + l * 3072}; gemm_phase(lds, Gemm{H, WIN + (size_t)3584 * 1024, NT, 3072, 1024, 1024, 1024, 0, 0}, S, E); } }
        GRID_SYNC(); PROBE_MARK(1);
#endif
#if !defined(ONLY) || ONLY == 2
        { PH_BEGIN
        { StaticOrder S; S.init(4096, 256, G, c); EpiHid E{(bf16_t*)(ws + WS_HID), (const float*)(ws + WS_B1)}; gemm_phase(lds, Gemm{(const bf16_t*)(ws + WS_KC), (const bf16_t*)(ws + WS_W1), 4096, 256, 2048, 1024, 2048, 0, 0}, S, E); }
        { StaticOrder S; S.init(4096, 256, G, c - 16); EpiHid E{(bf16_t*)(ws + WS_HID) + (size_t)4096 * 256, (const float*)(ws + WS_B1) + 256}; gemm_phase(lds, Gemm{(const bf16_t*)(ws + WS_VC), (const bf16_t*)(ws + WS_W1) + (size_t)256 * 2048, 4096, 256, 2048, 1024, 2048, 0, 0}, S, E); }
        { StaticOrder S; S.init(2048, 1024, G, c - 32); EpiPlain E{(bf16_t*)(ws + WS_MKV), 1024}; gemm_phase(lds, Gemm{HM, (const bf16_t*)(ws + WS_WKV), 2048, 1024, 1024, 1024, 1024, 0, 0}, S, E); } }
        { PH_BEGIN
        for (;;) { const int it = fetch_item(ctl + l * 8 + 0, slot); if (it >= 512) break; postproc_item(p, l, it, lds); } }
        { PH_BEGIN
        for (;;) { const int it = fetch_item(ctl + l * 8 + 4, slot); if (it >= 2048) break; gla_chunk_item<1>(p, l, it, lds); } }
        GRID_SYNC(); PROBE_MARK(2);
#endif
#if !defined(ONLY) || ONLY == 3
        { PH_BEGIN
        phase_c2(p, l, lds); }
        { PH_BEGIN
        gla_scan(p); }
        GRID_SYNC(); PROBE_MARK(3);
#endif
#if !defined(ONLY) || ONLY == 4
        { PH_BEGIN
#pragma unroll 1
        for (int k = 0; k < 8; ++k) { const int xq = (c + k) & 7;
            for (;;) { const int i = fetch_item(ctl + 32 + l * 8 + xq, slot); if (i >= 128) break; nsa_item(p, l, (i & 63) * 16 + 2 * xq + (i >> 6), lds); } } }
        { PH_BEGIN
        for (;;) { const int it = fetch_item(ctl + l * 8 + 1, slot); if (it >= 2048) break; gla_chunk_item<3>(p, l, it, lds); } }
        { PH_BEGIN
        for (;;) { const int it = fetch_item(ctl + l * 8 + 3, slot); if (it >= 512) break; mem_item(p, it, lds); } }
        GRID_SYNC(); PROBE_MARK(4);
#endif
#if !defined(ONLY) || ONLY == 5
        { PH_BEGIN
        { StaticOrder S; S.init(NT, 1024, G, c); EpiMerge<0> E{MG, Gb, 0}; gemm_phase(lds, Gemm{(const bf16_t*)(ws + WS_QN), (const bf16_t*)(ws + WS_WBR), NT, 1024, 512, 512, 512, 0, 0}, S, E); }
        { StaticOrder S; S.init(NT, 1024, G, c); EpiMerge<1> E{MG, Gb, 1}; gemm_phase(lds, Gemm{(const bf16_t*)(ws + WS_GR), (const bf16_t*)(ws + WS_WBR) + (size_t)1024 * 512, NT, 1024, 512, 512, 512, 0, 0}, S, E); }
        { StaticOrder S; S.init(NT, 1024, G, c); EpiMerge<1> E{MG, Gb, 2}; gemm_phase(lds, Gemm{(const bf16_t*)(ws + WS_MQ), (const bf16_t*)(ws + WS_WBR) + (size_t)2048 * 512, NT, 1024, 512, 512, 512, 0, 0}, S, E); } }
        GRID_SYNC(); PROBE_MARK(5);
#endif
#if !defined(ONLY) || ONLY == 6
        { PH_BEGIN
        { StaticOrder S; S.init(NT, 1024, G, c); EpiResid E{xin, p.out}; gemm_phase(lds, Gemm{MG, (const bf16_t*)(ws + WS_WOUT), NT, 1024, 1024, 1024, 1024, 0, 0}, S, E); } }
        GRID_SYNC(); PROBE_MARK(6);
#endif
#if !defined(ONLY) || ONLY == 7
        { PH_BEGIN
        phase_rmsnorm(p.out, p.in[I_LN_MLP] + l * 1024, H, NT); }
        GRID_SYNC(); PROBE_MARK(7);
#endif
#if !defined(ONLY) || ONLY == 8
        { PH_BEGIN
        { StaticOrder S; S.init(NT, 4096, G, c); EpiRelu2 E{U}; gemm_phase(lds, Gemm{H, (const bf16_t*)(ws + WS_WUP), NT, 4096, 1024, 1024, 1024, 0, 0}, S, E); } }
        GRID_SYNC(); PROBE_MARK(8);
#endif
#if !defined(ONLY) || ONLY == 9
        { PH_BEGIN
        { StaticOrder S; S.init(NT, 1024, G, c); EpiResid E{p.out, p.out}; gemm_phase(lds, Gemm{U, (const bf16_t*)(ws + WS_WDN2), NT, 1024, 4096, 4096, 4096, 1, 1}, S, E); } }
        GRID_SYNC(); PROBE_MARK(9);
#endif
    }
#if defined(PRX)
    { const unsigned long long q0 = (tacc0_ + 5000ull) / 10000ull, q1 = (tacc1_ + 5000ull) / 10000ull; const unsigned long long dl = q0 * 1000000ull + q1 * 10000ull;
      const unsigned long long ts = __builtin_amdgcn_s_memrealtime(); while (__builtin_amdgcn_s_memrealtime() - ts < dl) __builtin_amdgcn_s_sleep(32); }
#endif
}

extern "C" void kernel_launch(void* const* d_in, const int* in_sizes, int n_in, void* d_out, int out_size, void* d_ws, size_t ws_size, hipStream_t stream) {
    static int grid = 0;
    if (grid == 0) {
        if (n_in != 23 || ws_size < WS_END) { fprintf(stderr, "kernel_launch: unexpected inputs (%d) or workspace (%zu < %zu)\n", n_in, ws_size, (size_t)WS_END); grid = -1; return; }
        int dev = 0, cus = 0, per_cu = 0;
        hipGetDevice(&dev); hipDeviceGetAttribute(&cus, hipDeviceAttributeMultiprocessorCount, dev);
        if (hipFuncSetAttribute((const void*)fwd_kernel, hipFuncAttributeMaxDynamicSharedMemorySize, LDS_BYTES) != hipSuccess) { fprintf(stderr, "kernel_launch: hipFuncSetAttribute failed\n"); grid = -1; return; }
        if (hipOccupancyMaxActiveBlocksPerMultiprocessor(&per_cu, (const void*)fwd_kernel, 512, LDS_BYTES) != hipSuccess || per_cu < 1) { fprintf(stderr, "kernel_launch: occupancy query says %d\n", per_cu); per_cu = 1; }
        (void)hipGetLastError();
        grid = cus * 1;
    }
    if (grid < 0) return;
    hipMemsetAsync((char*)d_ws + WS_CTL, 0, 4096, stream);
    Params p{};
    for (int i = 0; i < 23; ++i) p.in[i] = (const float*)d_in[i];
    p.out = (float*)d_out; p.ws = (unsigned char*)d_ws;
    for (int i = 0; i < 8; ++i) p.inv_freq[i] = powf(500000.0f, -(float)i / 8.0f);
    void* args[] = {&p};
    hipError_t e = hipLaunchCooperativeKernel((const void*)fwd_kernel, dim3(grid), dim3(512), args, LDS_BYTES, stream);
    if (e != hipSuccess) fprintf(stderr, "cooperative launch failed: %s (grid %d)\n", hipGetErrorString(e), grid);
}
```
